# Optimizing an MI355X kernel written in HIP

```python
import math
import jax, jax.numpy as jnp
from jax import lax
import numpy as np

D_MODEL = 2048
BATCH = 4
SEQ = 2048
DEPTH = 2
DEC_BATCH = 128
DEC_SEQ = 8
PAST_LEN = 16384
PAGE_SIZE = 128

N_BRANCH = 3
BR_W = 1024
HG_HEADS = 8
HG_DK = 128
HG_DV = 128
F_MIN = 1e-30
RW_HEADS = 16
RW_N = 64
RW_DECAY_LORA = 96
RW_AAA_LORA = 96
RW_MV_LORA = 64
RW_SHIFT_W = 3 * BR_W + RW_DECAY_LORA + RW_AAA_LORA
RW_GN_EPS = 64e-5
RN_HEADS = 4
RN_DK = 256
RN_DV = 256
ROPE_BASE = 10000.0
CHUNK = 64
PLE_DIM = 256
EPS = 1e-6
IN_SIZES = (3 * BR_W, RW_SHIFT_W, 3 * BR_W, N_BRANCH * BR_W, N_BRANCH * D_MODEL)
D_IN = 3 * BR_W + RW_SHIFT_W + 3 * BR_W + N_BRANCH * BR_W + N_BRANCH * D_MODEL

kernel_name = 'hgrn2_rwkv7_retnet_parallel_decode_step'


def rmsnorm(x, g=None):
    xf = x.astype(jnp.float32)
    y = xf * lax.rsqrt(jnp.mean(xf * xf, axis=-1, keepdims=True) + EPS)
    if g is not None:
        y = y * g.astype(jnp.float32)
    return y.astype(x.dtype)


def _split(z, sizes):
    out, o = [], 0
    for s in sizes:
        out.append(z[..., o:o + s])
        o += s
    return out


def _heads(t, h):
    return t.reshape(t.shape[:-1] + (h, t.shape[-1] // h))


def _to_chunks(t, c):
    b, tt, h, x = t.shape
    return t.reshape(b, tt // c, c, h, x).transpose(1, 0, 3, 2, 4)


def _from_chunks(o):
    n, b, h, c, x = o.shape
    return o.transpose(1, 0, 3, 2, 4).reshape(b, n * c, h, x)


def rotary(x, pos):
    d = x.shape[-1]
    inv = ROPE_BASE ** (-jnp.arange(0, d, 2, dtype=jnp.float32) / d)
    ang = pos.astype(jnp.float32)[:, None] * inv[None, :]
    cos = jnp.cos(ang)[None, :, None, :]
    sin = jnp.sin(ang)[None, :, None, :]
    x1, x2 = x[..., : d // 2], x[..., d // 2:]
    return jnp.concatenate([x1 * cos - x2 * sin, x1 * sin + x2 * cos], axis=-1)


def token_shift(u, prev, mu):
    u_prev = jnp.concatenate([prev[:, None, :], u[:, :-1]], axis=1)
    return u + (u_prev - u) * mu, u[:, -1]


def gla_chunked(q, k, v, logf, s0):
    c = math.gcd(q.shape[1], CHUNK)
    tri = jnp.tril(jnp.ones((c, c), dtype=bool))[:, :, None]

    def step(s, blk):
        qc, kc, vc, gc = blk
        b = jnp.cumsum(gc, axis=2)
        diff = b[:, :, :, None, :] - b[:, :, None, :, :]
        dec = jnp.where(tri, jnp.exp(jnp.where(tri, diff, 0.0)), 0.0)
        att = jnp.einsum('bhtk,bhsk,bhtsk->bhts', qc, kc, dec)
        o = jnp.einsum('bhts,bhsv->bhtv', att, vc) + jnp.einsum('bhtk,bhkv->bhtv', qc * jnp.exp(b), s)
        bl = b[:, :, -1:]
        s = jnp.exp(bl[:, :, 0])[..., None] * s + jnp.einsum('bhsk,bhsv->bhkv', kc * jnp.exp(bl - b), vc)
        return s, o

    s, o = lax.scan(step, s0, (_to_chunks(q, c), _to_chunks(k, c), _to_chunks(v, c), _to_chunks(logf, c)))
    return _from_chunks(o), s


def retention_chunked(q, k, v, log_gamma, s0):
    c = math.gcd(q.shape[1], CHUNK)
    j = jnp.arange(c, dtype=jnp.float32)
    rel = j[:, None] - j[None, :]
    dmat = jnp.where(rel >= 0, jnp.exp(log_gamma[:, None, None] * jnp.maximum(rel, 0.0)), 0.0)
    q_dec = jnp.exp(log_gamma[:, None] * (j + 1.0))[..., None]
    k_dec = jnp.exp(log_gamma[:, None] * (c - 1.0 - j))[..., None]
    c_dec = jnp.exp(log_gamma * c)[:, None, None]

    def step(s, blk):
        qc, kc, vc = blk
        att = jnp.einsum('bhtk,bhsk->bhts', qc, kc) * dmat
        o = jnp.einsum('bhts,bhsv->bhtv', att, vc) + jnp.einsum('bhtk,bhkv->bhtv', qc, s) * q_dec
        s = c_dec * s + jnp.einsum('bhsk,bhsv->bhkv', kc * k_dec, vc)
        return s, o

    s, o = lax.scan(step, s0, (_to_chunks(q, c), _to_chunks(k, c), _to_chunks(v, c)))
    return _from_chunks(o), s


def rwkv7_scan(r, logw, k, v, a, b, s0):
    def step(s, inp):
        rt, wt, kt, vt, at, bt = inp
        sa = jnp.einsum('bhij,bhj->bhi', s, at)
        s = s * jnp.exp(wt)[:, :, None, :] + sa[..., None] * bt[:, :, None, :] + vt[..., None] * kt[:, :, None, :]
        return s, jnp.einsum('bhij,bhj->bhi', s, rt)

    xs = tuple(jnp.moveaxis(t, 1, 0) for t in (r, logw, k, v, a, b))
    s, y = lax.scan(step, s0, xs)
    return jnp.moveaxis(y, 0, 1), s


def _layer(l, x, p_l, pos, v_first, st_hg, st_rw, st_shift, st_rn, lb, log_gamma, prm):
    bsz, t, _ = x.shape
    f32 = jnp.float32
    h = rmsnorm(x, prm['norm_pre'][l])
    z = h @ prm['w_in'][l]
    z_hg, z_rw, z_rn, z_gate, z_merge = _split(z, IN_SIZES)

    hq, hf, hi = _split(z_hg.astype(f32), (BR_W, BR_W, BR_W))
    lb_l = lb[l]
    sig_f = jax.nn.sigmoid(hf)
    f_gate = lb_l + (1.0 - lb_l) * sig_f
    log_f = jnp.log(jnp.maximum(f_gate, F_MIN))
    k_hg = (1.0 - lb_l) * (1.0 - sig_f)
    q_hg = jax.nn.silu(hq) * HG_DK ** -0.5
    o_hg, s_hg = gla_chunked(_heads(q_hg, HG_HEADS), _heads(k_hg, HG_HEADS), _heads(hi, HG_HEADS),
                             _heads(log_f, HG_HEADS), st_hg.astype(f32))
    y_hg = rmsnorm(o_hg, prm['hg_norm'][l]).reshape(bsz, t, BR_W)

    u, shift_last = token_shift(z_rw, st_shift.astype(z_rw.dtype), prm['rw_mu'][l])
    r, wlo, k, v, alo = _split(u.astype(f32), (BR_W, RW_DECAY_LORA, BR_W, BR_W, RW_AAA_LORA))
    w = -jax.nn.softplus(-(prm['rw_w0'][l] + jnp.tanh(wlo) @ prm['rw_w2'][l])) - 0.5
    a = jax.nn.sigmoid(prm['rw_a0'][l] + alo @ prm['rw_a2'][l])
    kk = _heads(k * prm['rw_k_k'][l], RW_HEADS)
    kk = kk / jnp.maximum(jnp.sqrt(jnp.sum(kk * kk, axis=-1, keepdims=True)), 1e-12)
    k = k * (1.0 + (a - 1.0) * prm['rw_k_a'][l])
    if l == 0:
        v_first = v
    else:
        v = v + (v_first - v) * jax.nn.sigmoid(prm['rw_v0'][l - 1] + (v @ prm['rw_v1'][l - 1]) @ prm['rw_v2'][l - 1])
    rh, kh, vh, ah = (_heads(r, RW_HEADS), _heads(k, RW_HEADS), _heads(v, RW_HEADS), _heads(a, RW_HEADS))
    y_rw, s_rw = rwkv7_scan(rh, -jnp.exp(_heads(w, RW_HEADS)), kh, vh, -kk, kk * ah, st_rw.astype(f32))
    mu = jnp.mean(y_rw, axis=-1, keepdims=True)
    var = jnp.mean(jnp.square(y_rw - mu), axis=-1, keepdims=True)
    y_rw = (y_rw - mu) * lax.rsqrt(var + RW_GN_EPS) * _heads(prm['rw_ln_w'][l], RW_HEADS) + _heads(prm['rw_ln_b'][l], RW_HEADS)
    y_rw = y_rw + jnp.sum(rh * kh * prm['rw_r_k'][l], axis=-1, keepdims=True) * vh
    y_rw = y_rw.reshape(bsz, t, BR_W)

    rq, rk, rv = _split(z_rn.astype(f32), (BR_W, BR_W, BR_W))
    q_rn = rotary(_heads(rq, RN_HEADS), pos)
    k_rn = rotary(_heads(rk, RN_HEADS), pos) * RN_DK ** -0.5
    o_rn, s_rn = retention_chunked(q_rn, k_rn, _heads(rv, RN_HEADS), log_gamma, st_rn.astype(f32))
    y_rn = rmsnorm(o_rn).reshape(bsz, t, BR_W)

    ys = jnp.stack([y_hg, y_rw, y_rn], axis=2).astype(x.dtype)
    ys = ys * jax.nn.silu(z_gate.reshape(bsz, t, N_BRANCH, BR_W))
    proj = jnp.einsum('btnc,ncd->btnd', ys, prm['w_branch'][l])
    m = jnp.einsum('btnd,btnd->btd', jax.nn.sigmoid(z_merge.reshape(bsz, t, N_BRANCH, D_MODEL)), proj)
    x = x + rmsnorm(m @ prm['w_out'][l], prm['norm_post'][l])

    e = rmsnorm(p_l @ prm['ple_up'][l], prm['ple_norm'][l])
    x = x + e * jax.nn.sigmoid(x @ prm['ple_gate'][l])
    return x, v_first, (s_hg, s_rw, shift_last, s_rn)


def _trunk(x, p, st_hg, st_rw, st_shift, st_rn, pos, prm):
    sm = jax.nn.softmax(prm['hg_lower_bounds'].astype(jnp.float32), axis=0)
    lb = jnp.cumsum(sm, axis=0) - sm[0]
    log_gamma = jnp.log(1.0 - 2.0 ** (-5.0 - jnp.arange(RN_HEADS, dtype=jnp.float32)))
    v_first = None
    outs = []
    for l in range(DEPTH):
        x, v_first, st = _layer(l, x, p[l], pos, v_first, st_hg[l], st_rw[l], st_shift[l], st_rn[l], lb, log_gamma, prm)
        outs.append(st)
    new = [jnp.stack([o[i] for o in outs], axis=0).astype(x.dtype) for i in range(4)]
    return x, new[0], new[1], new[2], new[3]


def setup_inputs(seed: int = 0) -> dict:
    key = jax.random.key(seed)
    ks = jax.random.split(key, 32)
    f32 = jnp.float32

    def nrm(i, shape, s):
        return jax.random.normal(ks[i], shape, f32) * s

    def uni(i, shape, lo, hi):
        return jax.random.uniform(ks[i], shape, f32, lo, hi)

    L = DEPTH
    return {
        'x_prompt': nrm(0, (BATCH, SEQ, D_MODEL), 1.0),
        'x_sample': nrm(1, (DEC_BATCH, DEC_SEQ, D_MODEL), 1.0),
        'state_hgrn': nrm(2, (L, DEC_BATCH, HG_HEADS, HG_DK, HG_DV), 0.5),
        'state_rwkv': nrm(3, (L, DEC_BATCH, RW_HEADS, RW_N, RW_N), 0.3),
        'state_shift': nrm(4, (L, DEC_BATCH, RW_SHIFT_W), 1.0),
        'state_ret': nrm(5, (L, DEC_BATCH, RN_HEADS, RN_DK, RN_DV), 1.0),
        'p_prompt': nrm(6, (L, BATCH, SEQ, PLE_DIM), 1.0),
        'p_sample': nrm(7, (L, DEC_BATCH, DEC_SEQ, PLE_DIM), 1.0),
        'norm_pre': 1.0 + nrm(8, (L, D_MODEL), 0.02),
        'w_in': nrm(9, (L, D_MODEL, D_IN), D_MODEL ** -0.5),
        'hg_lower_bounds': nrm(10, (L, BR_W), 0.1),
        'hg_norm': 1.0 + nrm(11, (L, HG_DV), 0.02),
        'rw_mu': uni(12, (L, RW_SHIFT_W), 0.0, 1.0),
        'rw_w0': uni(13, (L, BR_W), -6.0, -1.0),
        'rw_w2': nrm(14, (L, RW_DECAY_LORA, BR_W), 0.5 * RW_DECAY_LORA ** -0.5),
        'rw_a0': nrm(15, (L, BR_W), 0.1),
        'rw_a2': nrm(16, (L, RW_AAA_LORA, BR_W), 0.5 * RW_AAA_LORA ** -0.5),
        'rw_k_k': 0.85 + nrm(17, (L, BR_W), 0.05),
        'rw_k_a': 1.0 + nrm(18, (L, BR_W), 0.05),
        'rw_v0': 1.0 + nrm(19, (L - 1, BR_W), 0.1),
        'rw_v1': nrm(20, (L - 1, BR_W, RW_MV_LORA), BR_W ** -0.5),
        'rw_v2': nrm(21, (L - 1, RW_MV_LORA, BR_W), 0.5 * RW_MV_LORA ** -0.5),
        'rw_r_k': nrm(22, (L, RW_HEADS, RW_N), 0.1),
        'rw_ln_w': 1.0 + nrm(23, (L, BR_W), 0.02),
        'rw_ln_b': nrm(24, (L, BR_W), 0.02),
        'w_branch': nrm(25, (L, N_BRANCH, BR_W, D_MODEL), BR_W ** -0.5),
        'w_out': nrm(26, (L, D_MODEL, D_MODEL), D_MODEL ** -0.5),
        'norm_post': 1.0 + nrm(27, (L, D_MODEL), 0.02),
        'ple_up': nrm(28, (L, PLE_DIM, D_MODEL), PLE_DIM ** -0.5),
        'ple_norm': 1.0 + nrm(29, (L, D_MODEL), 0.02),
        'ple_gate': nrm(30, (L, D_MODEL, D_MODEL), D_MODEL ** -0.5),
    }


def reference(x_prompt, x_sample, state_hgrn, state_rwkv, state_shift, state_ret, p_prompt, p_sample,
              norm_pre, w_in, hg_lower_bounds, hg_norm, rw_mu, rw_w0, rw_w2, rw_a0, rw_a2, rw_k_k, rw_k_a,
              rw_v0, rw_v1, rw_v2, rw_r_k, rw_ln_w, rw_ln_b, w_branch, w_out, norm_post, ple_up, ple_norm, ple_gate):
    prm = dict(norm_pre=norm_pre, w_in=w_in, hg_lower_bounds=hg_lower_bounds, hg_norm=hg_norm, rw_mu=rw_mu,
               rw_w0=rw_w0, rw_w2=rw_w2, rw_a0=rw_a0, rw_a2=rw_a2, rw_k_k=rw_k_k, rw_k_a=rw_k_a, rw_v0=rw_v0,
               rw_v1=rw_v1, rw_v2=rw_v2, rw_r_k=rw_r_k, rw_ln_w=rw_ln_w, rw_ln_b=rw_ln_b, w_branch=w_branch,
               w_out=w_out, norm_post=norm_post, ple_up=ple_up, ple_norm=ple_norm, ple_gate=ple_gate)
    f32 = jnp.float32
    bp, tp = x_prompt.shape[0], x_prompt.shape[1]
    ts = x_sample.shape[1]
    z_hg = jnp.zeros((DEPTH, bp, HG_HEADS, HG_DK, HG_DV), f32)
    z_rw = jnp.zeros((DEPTH, bp, RW_HEADS, RW_N, RW_N), f32)
    z_sh = jnp.zeros((DEPTH, bp, RW_SHIFT_W), x_prompt.dtype)
    z_rn = jnp.zeros((DEPTH, bp, RN_HEADS, RN_DK, RN_DV), f32)
    y_prompt, hg_p, rw_p, sh_p, rn_p = _trunk(x_prompt, p_prompt, z_hg, z_rw, z_sh, z_rn,
                                              jnp.arange(tp), prm)
    y_sample, hg_s, rw_s, sh_s, rn_s = _trunk(x_sample, p_sample, state_hgrn, state_rwkv, state_shift, state_ret,
                                              PAST_LEN + jnp.arange(ts), prm)
    return (y_prompt, y_sample, hg_p, hg_s, rw_p, rw_s, sh_p, sh_s, rn_p, rn_s)
```

```cpp
#include <hip/hip_runtime.h>
#include <hip/hip_cooperative_groups.h>
#include <cstdio>
namespace cg = cooperative_groups;

#define LAS __attribute__((address_space(3)))
typedef unsigned short bf16_t;
typedef short bf16x8 __attribute__((ext_vector_type(8)));
typedef float f32x4 __attribute__((ext_vector_type(4)));
typedef float f32x2 __attribute__((ext_vector_type(2)));
typedef unsigned u32x4 __attribute__((ext_vector_type(4)));
typedef unsigned u32x2 __attribute__((ext_vector_type(2)));

constexpr int NTHREADS = 512;
constexpr int LDS_MAIN = 143360;
constexpr int LDS_CTL_OFF = LDS_MAIN;
constexpr int LDS_BYTES = LDS_MAIN + 256;

constexpr int M = 9216, MP = 8192, D = 2048, NPAD = 18688, DIN = 18624;
constexpr int ZHQ = 0, ZHF = 1024, ZHI = 2048, ZR = 3072, ZK = 4096, ZV = 5120, ZWL = 6144, ZAL = 6240, ZRQ = 6400, ZRK = 7424, ZRV = 8448, ZG = 9472, ZM = 12544;
constexpr float EPS = 1e-6f;
constexpr size_t OFF_Y = 0, OFF_HGP = 18874368, OFF_HGS = 19922944, OFF_RWP = 53477376, OFF_RWS = 54001664, OFF_SHP = 70778880, OFF_SHS = 70804992, OFF_RNP = 71640576, OFF_RNS = 73737728;

constexpr size_t WS_CTL = 0, CTL_BYTES = 65536;
constexpr size_t WS_WIN = 65536;                                   constexpr size_t SZ_WIN = (size_t)2 * NPAD * 2048 * 2;
constexpr size_t WS_WBR = WS_WIN + SZ_WIN;                         constexpr size_t SZ_WBR = (size_t)6 * 2048 * 1024 * 2;
constexpr size_t WS_WOUT = WS_WBR + SZ_WBR;                        constexpr size_t SZ_WSQ = (size_t)2 * 2048 * 2048 * 2;
constexpr size_t WS_WGATE = WS_WOUT + SZ_WSQ;
constexpr size_t WS_WUP = WS_WGATE + SZ_WSQ;                       constexpr size_t SZ_WUP = (size_t)2 * 2048 * 256 * 2;
constexpr size_t WS_W2T = WS_WUP + SZ_WUP;                         constexpr size_t SZ_LORA = (size_t)2 * 1024 * 96 * 2;
constexpr size_t WS_A2T = WS_W2T + SZ_LORA;
constexpr size_t WS_V1T = WS_A2T + SZ_LORA;                        constexpr size_t SZ_V1 = (size_t)64 * 1024 * 2;
constexpr size_t WS_V2T = WS_V1T + SZ_V1;
constexpr size_t WS_ROPE = WS_V2T + SZ_V1;                         constexpr size_t SZ_ROPE = (size_t)2056 * 128 * 2 * 4;
constexpr size_t WS_XB = WS_ROPE + SZ_ROPE;                        constexpr size_t SZ_ACT2 = (size_t)M * 2048 * 2;
constexpr size_t WS_PB = WS_XB + SZ_ACT2;                          constexpr size_t SZ_PB = (size_t)2 * M * 256 * 2;
constexpr size_t WS_SS = WS_PB + SZ_PB;                            constexpr size_t SZ_SS = (size_t)7 * M * 4;
constexpr size_t WS_XL1 = WS_SS + SZ_SS;                           constexpr size_t SZ_ACT4 = (size_t)M * 2048 * 4;
constexpr size_t WS_Z = WS_XL1 + SZ_ACT4;                          constexpr size_t SZ_Z = (size_t)M * NPAD * 2;
constexpr size_t WS_DW = WS_Z + SZ_Z;                              constexpr size_t SZ_C4 = (size_t)M * 1024 * 4;
constexpr size_t WS_R = WS_DW + SZ_C4;                             constexpr size_t SZ_C2 = (size_t)M * 1024 * 2;
constexpr size_t WS_KK = WS_R + SZ_C2;
constexpr size_t WS_BB = WS_KK + SZ_C2;
constexpr size_t WS_KP = WS_BB + SZ_C2;
constexpr size_t WS_VB = WS_KP + SZ_C2;
constexpr size_t WS_BONUS = WS_VB + 2 * SZ_C2;                     constexpr size_t SZ_BONUS = (size_t)M * 16 * 4;
constexpr size_t WS_YRW = WS_BONUS + SZ_BONUS;
constexpr size_t WS_OHG = WS_YRW + SZ_C2;
constexpr size_t WS_ORN = WS_OHG + SZ_C2;
constexpr size_t WS_YS = WS_ORN + SZ_C2;                           constexpr size_t SZ_YS = (size_t)3 * M * 1024 * 2;
constexpr size_t WS_MB = WS_YS + SZ_YS;
constexpr size_t WS_ER = WS_MB + SZ_ACT2;
constexpr size_t WS_RWP = WS_ER + SZ_ACT2;                         constexpr size_t RWREC = 13056; constexpr size_t SZ_RWP = (size_t)10240 * RWREC;
constexpr size_t WS_END = WS_RWP + SZ_RWP;
constexpr size_t WS_HREC = WS_YS;
constexpr size_t WS_RQA = WS_XL1;
static_assert((size_t)512 * 33792 <= SZ_ACT4, "rqa overflow");
static_assert(WS_HREC + (size_t)1024 * 50688 <= WS_ER, "hrec alias must not reach e_raw (written in the first GEMM phase's tail)");
static_assert((size_t)512 * 131072 <= (size_t)18874368 * 4, "L records exceed the y region");
constexpr size_t WS_U = WS_Z;
constexpr size_t WS_XNF = WS_U + SZ_ACT2;
constexpr size_t WS_XNB = WS_XNF + SZ_ACT4;
static_assert(WS_XNB + SZ_ACT2 <= WS_Z + SZ_Z, "alias overflow");
constexpr int CW_Q = 4096;

typedef __bf16 bf16v2 __attribute__((ext_vector_type(2)));
__device__ __forceinline__ unsigned pk2(float lo, float hi) { bf16v2 v; v.x = (__bf16)lo; v.y = (__bf16)hi; return __builtin_bit_cast(unsigned, v); }
__device__ __forceinline__ float bflo(unsigned w) { return __uint_as_float(w << 16); }
__device__ __forceinline__ float bfhi(unsigned w) { return __uint_as_float(w & 0xffff0000u); }
__device__ __forceinline__ float bf2f(bf16_t b) { return __uint_as_float(((unsigned)b) << 16); }
__device__ __forceinline__ float rcpf_(float x) { return __builtin_amdgcn_rcpf(x); }
__device__ __forceinline__ float sigm(float x) { return rcpf_(1.f + __expf(-x)); }
__device__ __forceinline__ float siluf(float x) { return x * rcpf_(1.f + __expf(-x)); }
#define LDS_WAIT() asm volatile("s_waitcnt lgkmcnt(0)" ::: "memory")
template <int CTRL> __device__ __forceinline__ float dppf(float v) { return __int_as_float(__builtin_amdgcn_update_dpp(0, __float_as_int(v), CTRL, 0xF, 0xF, true)); }
__device__ __forceinline__ float red4(float v) { v += dppf<0xB1>(v); v += dppf<0x4E>(v); return v; }
__device__ __forceinline__ float red8(float v) { v = red4(v); v += dppf<0x141>(v); return v; }
__device__ __forceinline__ float red16(float v) { v = red8(v); v += dppf<0x140>(v); return v; }
__device__ __forceinline__ float wave_sum(float v) {
#pragma unroll
    for (int o = 1; o < 64; o <<= 1) v += __shfl_xor(v, o);
    return v;
}
__device__ __forceinline__ bf16x8 ldfrag(const LAS unsigned char* base, int off) { return *(const LAS bf16x8*)(base + off); }
#define MFMA16(a, b, c) __builtin_amdgcn_mfma_f32_16x16x32_bf16((a), (b), (c), 0, 0, 0)

#define XB_TMO      128
#define XB_XCNT(j)  (256  + 64 * (j))
#define XB_XSUB(j)  (1280 + 64 * (j))
#define XB_XGEN(j)  (2304 + 64 * (j))
#define XB_TOP      3328
#define XB_TOPGEN   3392
#define XCD_BAR_WORDS 3456
#define XB_SPIN_CAP (1u << 22)
__device__ __forceinline__ unsigned xb_ld(unsigned* p)              { return __hip_atomic_load(p, __ATOMIC_RELAXED, __HIP_MEMORY_SCOPE_AGENT); }
__device__ __forceinline__ unsigned xb_add(unsigned* p, unsigned v) { return __hip_atomic_fetch_add(p, v, __ATOMIC_RELAXED, __HIP_MEMORY_SCOPE_AGENT); }
__device__ __forceinline__ unsigned xb_xcc_id() { return (unsigned)__builtin_amdgcn_s_getreg((3 << 11) | 20) & 0xFu; }
#define XB_SPIN(cond, bar) do { unsigned _sp = 0; while (cond) { __builtin_amdgcn_s_sleep(1); \
    if ((++_sp & 255u) == 0u) { if (xb_ld(&(bar)[XB_TMO])) break; if (_sp > XB_SPIN_CAP) { atomicAdd(&(bar)[XB_TMO], 1u); break; } } } } while (0)
struct XcdBarrier { unsigned* bar; unsigned x; volatile LAS unsigned* st; };
__device__ __forceinline__ XcdBarrier xcd_barrier_post(unsigned* bar, volatile LAS unsigned* st) {
    XcdBarrier b; b.bar = bar; b.x = xb_xcc_id(); b.st = st;
    if (threadIdx.x == 0) (void)xb_add(&bar[XB_XCNT(b.x)], 1u);
    return b;
}
__device__ __forceinline__ void xcd_barrier_complete(unsigned* bar, unsigned x, unsigned& nloc, unsigned& nx) {
    const unsigned G = gridDim.x * gridDim.y * gridDim.z;
    unsigned sum, cnt, mine, sp = 0u;
    for (;;) {
        sum = 0u; cnt = 0u; mine = 0u;
#pragma unroll
        for (unsigned j = 0; j < 16; ++j) { const unsigned c = xb_ld(&bar[XB_XCNT(j)]); sum += c; cnt += (c > 0u) ? 1u : 0u; mine = (j == x) ? c : mine; }
        if (sum == G) break;
        __builtin_amdgcn_s_sleep(1);
        if ((++sp & 255u) == 0u) { if (xb_ld(&bar[XB_TMO])) break; if (sp > XB_SPIN_CAP) { atomicAdd(&bar[XB_TMO], 1u); break; } }
    }
    nloc = mine > 0u ? mine : 1u; nx = cnt > 0u ? cnt : 1u;
}
__device__ __forceinline__ void xcd_barrier(const XcdBarrier& b) {
    asm volatile("s_waitcnt vmcnt(0)" ::: "memory");
    __syncthreads();
    if (threadIdx.x == 0) {
        unsigned* bar = b.bar;
        __builtin_amdgcn_s_waitcnt(0);
        unsigned nloc = b.st[0], nx = b.st[1];
        if (nloc == 0u) { xcd_barrier_complete(bar, b.x, nloc, nx); b.st[0] = nloc; b.st[1] = nx; }
        const unsigned old = xb_add(&bar[XB_XSUB(b.x)], 1u);
        const unsigned gen = old / nloc;
        if (old + 1u == (gen + 1u) * nloc) {
            __builtin_amdgcn_fence(__ATOMIC_RELEASE, "agent");
            asm volatile("s_waitcnt vmcnt(0)" ::: "memory");
            const unsigned og = xb_add(&bar[XB_TOP], 1u);
            const unsigned tg = og / nx;
            if (og + 1u == (tg + 1u) * nx) xb_add(&bar[XB_TOPGEN], 1u);
            else XB_SPIN(xb_ld(&bar[XB_TOPGEN]) == tg, bar);
            __builtin_amdgcn_fence(__ATOMIC_ACQUIRE, "agent");
            xb_add(&bar[XB_XGEN(b.x)], 1u);
            asm volatile("s_waitcnt vmcnt(0)" ::: "memory");
        } else {
            XB_SPIN(xb_ld(&bar[XB_XGEN(b.x)]) == gen, bar);
            __builtin_amdgcn_fence(__ATOMIC_ACQUIRE, "agent");
            asm volatile("s_waitcnt vmcnt(0)" ::: "memory");
        }
    }
    __syncthreads();
}

namespace pg8 {
#define PG8_LAS __attribute__((address_space(3)))
constexpr int BM = 256, BK = 64, HALF = 128, HTB = HALF * BK * 2, STAGE_BYTES = 8 * HTB, NXCD = 8, WGM = 8;
__host__ __device__ __forceinline__ int lds_byte(int r, int c) { const int st = (r >> 4) * 2 + (c >> 5), rr = r & 15, cc = c & 31, ob = rr * 64 + cc * 2; return st * 1024 + (ob ^ (((ob >> 9) & 1) << 5)); }
__host__ __device__ __forceinline__ void stage_rc(int b, int& R, int& C) { const int st = b / 1024, sb = b % 1024, swz = sb ^ (((sb >> 9) & 1) << 5); R = (st >> 1) * 16 + swz / 64; C = (st & 1) * 32 + (swz % 64) / 2; }
__host__ __device__ __forceinline__ int perm32(int rho) { const int n = rho >> 4, i = rho & 15; return 8 * (i >> 2) + 4 * n + (i & 3); }
struct Unit { int pm, pn, fl; };
struct Gemm { const bf16_t* A; const bf16_t* Bt; int M, N, K; };
struct StaticOrder {
    int nM, nN, nwg, G, c;
    __host__ __device__ void init(int M_, int N_, int G_, int c_) { nM = M_ / BM; nN = N_ / BM; nwg = nM * nN; G = G_; c = c_; }
    __host__ __device__ __forceinline__ bool tile(long L, Unit& u) const {
        if (L >= nwg) return false;
        int wgid = (int)L; { const int q = nwg / NXCD, r = nwg % NXCD, xcd = wgid % NXCD, off = wgid / NXCD; wgid = (xcd < r ? xcd * (q + 1) : r * (q + 1) + (xcd - r) * q) + off; }
        const int nig = WGM * nN, gid = wgid / nig, fm = gid * WGM, gsz = (nM - fm) < WGM ? (nM - fm) : WGM;
        u.pm = fm + ((wgid % nig) % gsz); u.pn = (wgid % nig) / gsz; u.fl = 0; return true;
    }
    __host__ __device__ __forceinline__ bool next(int i, Unit& u) const { return tile((long)i * G + c, u); }
    __device__ __forceinline__ void a_ready(const Unit&) const {}
    __device__ __forceinline__ void done(const Unit&) const {}
};
struct BranchOrder {
    StaticOrder s;
    __device__ __forceinline__ bool next(int i, Unit& u) const { Unit t; if (i >= 3 || !s.tile((long)s.c, t)) return false; u.pm = i * 36 + t.pm; u.pn = i * 8 + t.pn; u.fl = 0; return true; }
    __device__ __forceinline__ void a_ready(const Unit&) const {}
    __device__ __forceinline__ void done(const Unit&) const {}
};
struct SingleOrder {
    int pm, pn;
    __device__ __forceinline__ bool next(int i, Unit& u) const { if (i != 0) return false; u.pm = pm; u.pn = pn; u.fl = 0; return true; }
    __device__ __forceinline__ void a_ready(const Unit&) const {}
    __device__ __forceinline__ void done(const Unit&) const {}
};
struct ExtraOrder {
    StaticOrder s;
    __device__ __forceinline__ bool next(int i, Unit& u) const { Unit t; if (i != 0 || s.c < 160) return false; const int e = s.c - 160, sp = e / 3, n = e - 3 * sp; if (!s.tile((long)(256 + sp), t)) return false;
        u.pm = n * 36 + t.pm; u.pn = n * 8 + t.pn; u.fl = 1 + sp; return true; }
    __device__ __forceinline__ void a_ready(const Unit&) const {}
    __device__ __forceinline__ void done(const Unit&) const {}
};

template <class Epi, class Sched>
__device__ __forceinline__ void gemm_phase(PG8_LAS unsigned char* lds, const Gemm g, const Sched& S, const Epi& E) {
    int tid = threadIdx.x; asm volatile("" : "+v"(tid));
    const int wid = __builtin_amdgcn_readfirstlane(tid >> 6), lane = tid & 63, wr = wid >> 2, wc = wid & 3, fr = lane & 15, fq = lane >> 4;
    const int K = g.K, nt = K / BK;
    unsigned voffA[2], voffB[2];
#pragma unroll
    for (int i = 0; i < 2; ++i) { int R, C; stage_rc(tid * 16 + i * 8192, R, C); const int Rb = Epi::PERM ? ((R & ~31) + perm32(R & 31)) : R;
        voffA[i] = (unsigned)(R * K + C) * 2u; voffB[i] = (unsigned)(Rb * K + C) * 2u; }
    const size_t kstep = (size_t)(BK * 2);
    const size_t hstep = (size_t)HALF * K * 2;
    const size_t tstep = 2 * hstep;
    const unsigned ldsw = (unsigned)wid * 1024u;
    const int aoff = lds_byte(wr * 64 + fr, fq * 8), boff = lds_byte(wc * 32 + fr, fq * 8);
#define PG8_SA(b, h) (((b) * 2 + (h)) * HTB)
#define PG8_SB(b, h) ((4 + (b) * 2 + (h)) * HTB)
#define PG8_STAGE(bufoff, gbase, voff) do { _Pragma("unroll") for (int _i = 0; _i < 2; ++_i) \
        __builtin_amdgcn_global_load_lds((const unsigned*)((const char*)(gbase) + (voff)[_i]), (PG8_LAS unsigned*)(lds + (bufoff) + ldsw + _i * 8192), 16, 0, 0); } while (0)
#define PG8_LDA(dst, b, h) do { _Pragma("unroll") for (int m = 0; m < 4; ++m) _Pragma("unroll") for (int k = 0; k < 2; ++k) dst[m][k] = *(const PG8_LAS bf16x8*)(lds + PG8_SA(b, h) + aoff + m * 2048 + k * 1024); } while (0)
#define PG8_LDB(dst, b, h) do { _Pragma("unroll") for (int n = 0; n < 2; ++n) _Pragma("unroll") for (int k = 0; k < 2; ++k) dst[n][k] = *(const PG8_LAS bf16x8*)(lds + PG8_SB(b, h) + boff + n * 2048 + k * 1024); } while (0)
#define PG8_MMA(ai, bj, At, Bt) do { __builtin_amdgcn_s_setprio(1); _Pragma("unroll") for (int m = 0; m < 4; ++m) _Pragma("unroll") for (int n = 0; n < 2; ++n) _Pragma("unroll") for (int k = 0; k < 2; ++k) \
        acc[ai][bj][m][n] = __builtin_amdgcn_mfma_f32_16x16x32_bf16(Bt[n][k], At[m][k], acc[ai][bj][m][n], 0, 0, 0); __builtin_amdgcn_s_setprio(0); } while (0)
#define PG8_WAIT_V(n) asm volatile("s_waitcnt vmcnt(" #n ")" ::: "memory")
#define PG8_WAIT_L(n) asm volatile("s_waitcnt lgkmcnt(" #n ")" ::: "memory")
#define PG8_BAR __builtin_amdgcn_s_barrier()
#define PG8_SCHED __builtin_amdgcn_sched_barrier(0)
    Unit cur, nxt; int ui = 0;
    if (!S.next(0, cur)) return;
    f32x4 acc[2][2][4][2];
#pragma unroll
    for (int a = 0; a < 2; ++a)
#pragma unroll
        for (int b = 0; b < 2; ++b)
#pragma unroll
            for (int m = 0; m < 4; ++m)
#pragma unroll
                for (int n = 0; n < 2; ++n) acc[a][b][m][n] = (f32x4){0.f, 0.f, 0.f, 0.f};
    bf16x8 At[4][2], B0[2][2], B1[2][2];
    const char* cA = (const char*)g.A + (size_t)cur.pm * tstep; const char* cB = (const char*)g.Bt + (size_t)cur.pn * tstep;
    S.a_ready(cur);
    PG8_STAGE(PG8_SB(0, 0), cB, voffB); PG8_STAGE(PG8_SA(0, 0), cA, voffA); PG8_STAGE(PG8_SB(0, 1), cB + hstep, voffB); PG8_STAGE(PG8_SA(0, 1), cA + hstep, voffA);
    if (wr == 1) PG8_BAR;
    PG8_WAIT_V(4); PG8_BAR;
    PG8_STAGE(PG8_SB(1, 0), cB + kstep, voffB); PG8_STAGE(PG8_SA(1, 0), cA + kstep, voffA); PG8_STAGE(PG8_SB(1, 1), cB + hstep + kstep, voffB);
    PG8_WAIT_V(6); PG8_BAR;
    for (;;) {
        const bool has_next = S.next(ui + 1, nxt);
        const char* nA = has_next ? (const char*)g.A + (size_t)nxt.pm * tstep : cA; const char* nB = has_next ? (const char*)g.Bt + (size_t)nxt.pn * tstep : cB;
        for (int t = 0; t < nt; t += 2) {
            const bool last = (t == nt - 2);
            const char* a1 = cA + (size_t)(t + 1) * kstep;
            const char* a2 = last ? nA : cA + (size_t)(t + 2) * kstep; const char* b2 = last ? nB : cB + (size_t)(t + 2) * kstep;
            const char* a3 = a2 + kstep; const char* b3 = b2 + kstep;
            if (last && has_next) S.a_ready(nxt);
            PG8_LDB(B0, 0, 0); PG8_SCHED; PG8_LDA(At, 0, 0); PG8_STAGE(PG8_SA(1, 1), a1 + hstep, voffA);
            PG8_WAIT_L(8); PG8_BAR; PG8_WAIT_L(0); PG8_MMA(0, 0, At, B0); PG8_BAR; PG8_SCHED;
            PG8_LDB(B1, 0, 1); PG8_STAGE(PG8_SB(0, 0), b2, voffB);
            PG8_BAR; PG8_WAIT_L(0); PG8_MMA(0, 1, At, B1); PG8_BAR;
            PG8_LDA(At, 0, 1); PG8_STAGE(PG8_SA(0, 0), a2, voffA);
            PG8_BAR; PG8_WAIT_L(0); PG8_MMA(1, 0, At, B0); PG8_BAR; PG8_SCHED;
            PG8_STAGE(PG8_SB(0, 1), b2 + hstep, voffB);
            PG8_WAIT_V(6); PG8_BAR; PG8_MMA(1, 1, At, B1); PG8_BAR;
            PG8_LDB(B0, 1, 0); PG8_SCHED; PG8_LDA(At, 1, 0); PG8_STAGE(PG8_SA(0, 1), a2 + hstep, voffA);
            PG8_WAIT_L(8); PG8_BAR; PG8_WAIT_L(0); PG8_MMA(0, 0, At, B0); PG8_BAR; PG8_SCHED;
            PG8_LDB(B1, 1, 1); PG8_STAGE(PG8_SB(1, 0), b3, voffB);
            PG8_BAR; PG8_WAIT_L(0); PG8_MMA(0, 1, At, B1); PG8_BAR;
            PG8_LDA(At, 1, 1); PG8_STAGE(PG8_SA(1, 0), a3, voffA);
            PG8_BAR; PG8_WAIT_L(0); PG8_MMA(1, 0, At, B0); PG8_BAR; PG8_SCHED;
            PG8_STAGE(PG8_SB(1, 1), b3 + hstep, voffB);
            PG8_WAIT_V(6); PG8_BAR; PG8_MMA(1, 1, At, B1); PG8_BAR;
        }
        const bool clear_acc = E(acc, cur, wr, wc, fr, fq); S.done(cur);
        if (!has_next) break;
        if (clear_acc)
#pragma unroll
        for (int a = 0; a < 2; ++a)
#pragma unroll
            for (int b = 0; b < 2; ++b)
#pragma unroll
                for (int m = 0; m < 4; ++m)
#pragma unroll
                    for (int n = 0; n < 2; ++n) acc[a][b][m][n] = (f32x4){0.f, 0.f, 0.f, 0.f};
        cur = nxt; cA = nA; cB = nB; ++ui;
    }
    PG8_WAIT_V(0);
    if (wr == 0) PG8_BAR;
    PG8_BAR;
#undef PG8_SA
#undef PG8_SB
#undef PG8_STAGE
#undef PG8_LDA
#undef PG8_LDB
#undef PG8_MMA
#undef PG8_WAIT_V
#undef PG8_WAIT_L
#undef PG8_BAR
#undef PG8_SCHED
}
}

struct EpiZ {
    static constexpr bool PERM = true;
    bf16_t* Z; const float* ssx;
    __device__ __forceinline__ bool operator()(f32x4 (&acc)[2][2][4][2], const pg8::Unit& u, int wr, int wc, int fr, int fq) const {
        const int row0 = u.pm * 256 + wr * 64 + fr, col0 = u.pn * 256 + wc * 32 + 8 * fq;
        float ss[2][4];
#pragma unroll
        for (int ai = 0; ai < 2; ++ai)
#pragma unroll
            for (int m = 0; m < 4; ++m) ss[ai][m] = ssx[row0 + ai * 128 + m * 16];
#pragma unroll
        for (int ai = 0; ai < 2; ++ai)
#pragma unroll
            for (int m = 0; m < 4; ++m) { const int row = row0 + ai * 128 + m * 16; const float rs = rsqrtf(ss[ai][m] * (1.0f / 2048.0f) + EPS);
                bf16_t* rowp = Z + (size_t)row * NPAD + col0;
#pragma unroll
                for (int bj = 0; bj < 2; ++bj) { const f32x4 v0 = acc[ai][bj][m][0] * rs, v1 = acc[ai][bj][m][1] * rs;
                    u32x4 w; w.x = pk2(v0[0], v0[1]); w.y = pk2(v0[2], v0[3]); w.z = pk2(v1[0], v1[1]); w.w = pk2(v1[2], v1[3]);
                    *(u32x4*)(rowp + bj * 128) = w; } }
        return true;
    }
};
struct EpiBranch {
    static constexpr bool PERM = true;
    const bf16_t* Z; bf16_t* Mb;
    __device__ __forceinline__ bool operator()(f32x4 (&acc)[2][2][4][2], const pg8::Unit& u, int wr, int wc, int fr, int fq) const {
        const int n = u.pm / 36, pm = u.pm - 36 * n, pn = u.pn - 8 * n;
        const int row0 = pm * 256 + wr * 64 + fr, col0 = pn * 256 + wc * 32 + 8 * fq;
        const int nx = n < 2 ? 2048 : 0;
        u32x4 zg[2][2], zn[2][2];
#pragma unroll
        for (int bj = 0; bj < 2; ++bj) { const bf16_t* zp = Z + (size_t)row0 * NPAD + ZM + n * 2048 + col0 + bj * 128; zg[0][bj] = *(const u32x4*)zp; zn[0][bj] = *(const u32x4*)(zp + nx); }
#pragma unroll
        for (int gi = 0; gi < 8; ++gi) {
            if (gi < 7) { const int row = row0 + ((gi + 1) >> 2) * 128 + ((gi + 1) & 3) * 16;
#pragma unroll
                for (int bj = 0; bj < 2; ++bj) { const bf16_t* zp = Z + (size_t)row * NPAD + ZM + n * 2048 + col0 + bj * 128; zg[(gi + 1) & 1][bj] = *(const u32x4*)zp; zn[(gi + 1) & 1][bj] = *(const u32x4*)(zp + nx); } }
            __builtin_amdgcn_sched_barrier(0);
            const int ai = gi >> 2, m = gi & 3, row = row0 + ai * 128 + m * 16;
#pragma unroll
            for (int bj = 0; bj < 2; ++bj) { const int col = col0 + bj * 128;
                const u32x4 g = zg[gi & 1][bj], h = zn[gi & 1][bj];
                float f[8];
                const float zc[8] = {bflo(g.x), bfhi(g.x), bflo(g.y), bfhi(g.y), bflo(g.z), bfhi(g.z), bflo(g.w), bfhi(g.w)};
                const float zx[8] = {bflo(h.x), bfhi(h.x), bflo(h.y), bfhi(h.y), bflo(h.z), bfhi(h.z), bflo(h.w), bfhi(h.w)};
#pragma unroll
                for (int e = 0; e < 8; ++e) { const float ic = rcpf_(1.f + __expf(-zc[e])); f[e] = (n < 2) ? ic * (1.f + __expf(-zx[e])) : ic; }
                f32x4 v0 = acc[ai][bj][m][0], v1 = acc[ai][bj][m][1];
                v0[0] *= f[0]; v0[1] *= f[1]; v0[2] *= f[2]; v0[3] *= f[3]; v1[0] *= f[4]; v1[1] *= f[5]; v1[2] *= f[6]; v1[3] *= f[7];
                acc[ai][bj][m][0] = v0; acc[ai][bj][m][1] = v1;
                if (n == 2) { u32x4 w; w.x = pk2(v0[0], v0[1]); w.y = pk2(v0[2], v0[3]); w.z = pk2(v1[0], v1[1]); w.w = pk2(v1[2], v1[3]);
                    *(u32x4*)(Mb + (size_t)row * 2048 + col) = w; } }
            __builtin_amdgcn_sched_barrier(0);
        }
        return n == 2;
    }
};
struct EpiBranchAtomic {
    static constexpr bool PERM = true;
    const bf16_t* Z; bf16_t* SP;
    __device__ __forceinline__ bool operator()(f32x4 (&acc)[2][2][4][2], const pg8::Unit& u, int wr, int wc, int fr, int fq) const {
        const int n = u.pm / 36, pm = u.pm - 36 * n, pn = u.pn - 8 * n;
        const int rl0 = wr * 64 + fr, cl0 = wc * 32 + 8 * fq;
        bf16_t* sp = SP + (size_t)(n * 32 + u.fl - 1) * 65536;
        const bf16_t* zb = Z + (size_t)(pm * 256 + rl0) * NPAD + ZM + n * 2048 + pn * 256 + cl0;
        u32x4 zg[2][2];
#pragma unroll
        for (int bj = 0; bj < 2; ++bj) zg[0][bj] = *(const u32x4*)(zb + bj * 128);
#pragma unroll
        for (int gi = 0; gi < 8; ++gi) {
            if (gi < 7) {
#pragma unroll
                for (int bj = 0; bj < 2; ++bj) zg[(gi + 1) & 1][bj] = *(const u32x4*)(zb + (size_t)(((gi + 1) >> 2) * 128 + ((gi + 1) & 3) * 16) * NPAD + bj * 128); }
            __builtin_amdgcn_sched_barrier(0);
            const int ai = gi >> 2, m = gi & 3;
#pragma unroll
            for (int bj = 0; bj < 2; ++bj) { const int rl = rl0 + ai * 128 + m * 16, cl = cl0 + bj * 128; const u32x4 g = zg[gi & 1][bj];
                const f32x4 v0 = acc[ai][bj][m][0], v1 = acc[ai][bj][m][1];
                u32x4 w; w.x = pk2(v0[0] * sigm(bflo(g.x)), v0[1] * sigm(bfhi(g.x))); w.y = pk2(v0[2] * sigm(bflo(g.y)), v0[3] * sigm(bfhi(g.y)));
                w.z = pk2(v1[0] * sigm(bflo(g.z)), v1[1] * sigm(bfhi(g.z))); w.w = pk2(v1[2] * sigm(bflo(g.w)), v1[3] * sigm(bfhi(g.w)));
                *(u32x4*)(sp + rl * 256 + cl) = w; }
            __builtin_amdgcn_sched_barrier(0);
        }
        return true;
    }
};
struct EpiSS {
    static constexpr bool PERM = true;
    bf16_t* O; float* ss;
    __device__ __forceinline__ bool operator()(f32x4 (&acc)[2][2][4][2], const pg8::Unit& u, int wr, int wc, int fr, int fq) const {
        const int row0 = u.pm * 256 + wr * 64 + fr, col0 = u.pn * 256 + wc * 32 + 8 * fq;
#pragma unroll
        for (int ai = 0; ai < 2; ++ai)
#pragma unroll
            for (int m = 0; m < 4; ++m) { const int row = row0 + ai * 128 + m * 16; float s = 0.f;
#pragma unroll
                for (int bj = 0; bj < 2; ++bj) { const f32x4 v0 = acc[ai][bj][m][0], v1 = acc[ai][bj][m][1];
                    s += (v0[0] * v0[0] + v0[1] * v0[1]) + (v0[2] * v0[2] + v0[3] * v0[3]) + (v1[0] * v1[0] + v1[1] * v1[1]) + (v1[2] * v1[2] + v1[3] * v1[3]);
                    u32x4 w; w.x = pk2(v0[0], v0[1]); w.y = pk2(v0[2], v0[3]); w.z = pk2(v1[0], v1[1]); w.w = pk2(v1[2], v1[3]);
                    *(u32x4*)(O + (size_t)row * 2048 + col0 + bj * 128) = w; }
                s += __shfl_xor(s, 16); s += __shfl_xor(s, 32);
                if (fq == 0) atomicAdd(ss + row, s); }
        return true;
    }
};
struct EpiGate {
    static constexpr bool PERM = true;
    const bf16_t* XN; const bf16_t* ER; const float* sse; const float* pnorm; float* XO; bf16_t* XB; float* ssx;
    __device__ __forceinline__ bool operator()(f32x4 (&acc)[2][2][4][2], const pg8::Unit& u, int wr, int wc, int fr, int fq) const {
        const int row0 = u.pm * 256 + wr * 64 + fr, col0 = u.pn * 256 + wc * 32 + 8 * fq;
        f32x4 pn[2][2];
#pragma unroll
        for (int bj = 0; bj < 2; ++bj) { pn[bj][0] = *(const f32x4*)(pnorm + col0 + bj * 128); pn[bj][1] = *(const f32x4*)(pnorm + col0 + bj * 128 + 4); }
        u32x4 xv[2][2], ev[2][2]; float rsv[2];
        rsv[0] = sse[row0];
#pragma unroll
        for (int bj = 0; bj < 2; ++bj) { const size_t off = (size_t)row0 * 2048 + col0 + bj * 128; xv[0][bj] = *(const u32x4*)(XN + off); ev[0][bj] = *(const u32x4*)(ER + off); }
#pragma unroll
        for (int g = 0; g < 8; ++g) {
            if (g < 7) { const int row = row0 + ((g + 1) >> 2) * 128 + ((g + 1) & 3) * 16; rsv[(g + 1) & 1] = sse[row];
#pragma unroll
                for (int bj = 0; bj < 2; ++bj) { const size_t off = (size_t)row * 2048 + col0 + bj * 128; xv[(g + 1) & 1][bj] = *(const u32x4*)(XN + off); ev[(g + 1) & 1][bj] = *(const u32x4*)(ER + off); } }
            __builtin_amdgcn_sched_barrier(0);
            {
                const int ai = g >> 2, m = g & 3;
                const int row = row0 + ai * 128 + m * 16;
                float s = 0.f; const float rs = rsqrtf(rsv[g & 1] * (1.0f / 2048.0f) + EPS);
#pragma unroll
                for (int bj = 0; bj < 2; ++bj) { const size_t off = (size_t)row * 2048 + col0 + bj * 128;
                    const f32x4 p0 = pn[bj][0], p1 = pn[bj][1];
                    const u32x4 e = ev[g & 1][bj], x = xv[g & 1][bj]; const f32x4 a0 = acc[ai][bj][m][0], a1 = acc[ai][bj][m][1];
                    f32x4 o0, o1;
                    o0[0] = bflo(x.x) + bflo(e.x) * rs * p0[0] * sigm(a0[0]); o0[1] = bfhi(x.x) + bfhi(e.x) * rs * p0[1] * sigm(a0[1]);
                    o0[2] = bflo(x.y) + bflo(e.y) * rs * p0[2] * sigm(a0[2]); o0[3] = bfhi(x.y) + bfhi(e.y) * rs * p0[3] * sigm(a0[3]);
                    o1[0] = bflo(x.z) + bflo(e.z) * rs * p1[0] * sigm(a1[0]); o1[1] = bfhi(x.z) + bfhi(e.z) * rs * p1[1] * sigm(a1[1]);
                    o1[2] = bflo(x.w) + bflo(e.w) * rs * p1[2] * sigm(a1[2]); o1[3] = bfhi(x.w) + bfhi(e.w) * rs * p1[3] * sigm(a1[3]);
                    if (XO) { *(f32x4*)(XO + off) = o0; *(f32x4*)(XO + off + 4) = o1; }
                    if (XB) { u32x4 w; w.x = pk2(o0[0], o0[1]); w.y = pk2(o0[2], o0[3]); w.z = pk2(o1[0], o1[1]); w.w = pk2(o1[2], o1[3]); *(u32x4*)(XB + off) = w;
                        s += (o0[0] * o0[0] + o0[1] * o0[1]) + (o0[2] * o0[2] + o0[3] * o0[3]) + (o1[0] * o1[0] + o1[1] * o1[1]) + (o1[2] * o1[2] + o1[3] * o1[3]); } }
                if (XB) { s += __shfl_xor(s, 16); s += __shfl_xor(s, 32); if (fq == 0) atomicAdd(ssx + row, s); }
            }
            __builtin_amdgcn_sched_barrier(0);
        }
        return true;
    }
};

struct Params { const float* in[31]; float* out; unsigned char* ws; };
struct Ctx {
    float* out; unsigned char* ws;
    LAS unsigned char* lds; int tid, lane, wave, G, bid;
    unsigned* ctl;
};
#define WSP(T, off) ((T*)(C.ws + (off)))
#define WSPL(T, off) ((T*)(CL.ws + (off)))

__device__ __forceinline__ int win_src(int n0) {
    if (n0 < 4096) return n0;
    if (n0 < 6144) return n0 + 96;
    if (n0 < 6240) return n0 - 2048;
    if (n0 < 6336) return n0;
    if (n0 < 6400) return -1;
    return n0 - 64;
}
__device__ __forceinline__ void tr_item(const float* W, int ldw, int srccol0, const float* gk, int k0, bf16_t* WT, int K, int n0, LAS float* scr, int lane) {
    const int r8 = lane >> 3, c4 = (lane & 7) * 4;
    f32x4 v[8]; float gs[8];
    const int sc0 = srccol0 >= 0 ? srccol0 : 0; const float zs = srccol0 >= 0 ? 1.f : 0.f; const float* gp = gk ? gk : W;
#pragma unroll
    for (int i = 0; i < 8; ++i) { v[i] = *(const f32x4*)(W + (size_t)(k0 + 8 * i + r8) * ldw + sc0 + c4); const float gv = gp[k0 + 8 * i + r8]; gs[i] = gk ? gv * zs : zs; }
#pragma unroll
    for (int i = 0; i < 8; ++i) { LAS float* d = scr + (8 * i + r8) * 33 + c4; d[0] = v[i][0] * gs[i]; d[1] = v[i][1] * gs[i]; d[2] = v[i][2] * gs[i]; d[3] = v[i][3] * gs[i]; }
    LDS_WAIT();
    const int c = lane & 7;
#pragma unroll
    for (int j = 0; j < 4; ++j) { const int n = (lane >> 3) + 8 * j; const LAS float* s = scr + (8 * c) * 33 + n;
        u32x4 o; o.x = pk2(s[0 * 33], s[1 * 33]); o.y = pk2(s[2 * 33], s[3 * 33]); o.z = pk2(s[4 * 33], s[5 * 33]); o.w = pk2(s[6 * 33], s[7 * 33]);
        *(u32x4*)(WT + (size_t)(n0 + n) * K + k0 + 8 * c) = o; }
    LDS_WAIT();
}
constexpr int CONV_ITEMS = 26112, CONV_SPLIT = 11000;
__device__ __forceinline__ void conv_layer_items(const Params& P, const Ctx& C, int l, int lo, int hi, int gwf, int ngwf) {
    int lane = C.lane; asm volatile("" : "+v"(lane));
    LAS float* scr = (LAS float*)(C.lds + C.wave * 8448);
    for (int it = lo + gwf; it < hi; it += ngwf) {
        int r = it;
        if (r < 18688) { const int kb = r / 584, nb = r - kb * 584;
            tr_item(P.in[9] + (size_t)l * 2048 * DIN, DIN, win_src(32 * nb), P.in[8] + l * 2048, 64 * kb, WSP(bf16_t, WS_WIN) + (size_t)l * NPAD * 2048, 2048, 32 * nb, scr, lane); continue; }
        r -= 18688;
        if (r < 3072) { const int n = r / 1024; r -= n * 1024; const int ln = l * 3 + n, kb = r / 64, nb = r - kb * 64;
            tr_item(P.in[25] + (size_t)ln * 1024 * 2048, 2048, 32 * nb, nullptr, 64 * kb, WSP(bf16_t, WS_WBR) + (size_t)ln * 2048 * 1024, 1024, 32 * nb, scr, lane); continue; }
        r -= 3072;
        if (r < 2048) { const int kb = r / 64, nb = r - kb * 64;
            tr_item(P.in[26] + (size_t)l * 2048 * 2048, 2048, 32 * nb, nullptr, 64 * kb, WSP(bf16_t, WS_WOUT) + (size_t)l * 2048 * 2048, 2048, 32 * nb, scr, lane); continue; }
        r -= 2048;
        if (r < 2048) { const int kb = r / 64, nb = r - kb * 64;
            tr_item(P.in[30] + (size_t)l * 2048 * 2048, 2048, 32 * nb, nullptr, 64 * kb, WSP(bf16_t, WS_WGATE) + (size_t)l * 2048 * 2048, 2048, 32 * nb, scr, lane); continue; }
        r -= 2048;
        { const int kb = r / 64, nb = r - kb * 64;
            tr_item(P.in[28] + (size_t)l * 256 * 2048, 2048, 32 * nb, nullptr, 64 * kb, WSP(bf16_t, WS_WUP) + (size_t)l * 2048 * 256, 256, 32 * nb, scr, lane); }
    }
}
__device__ __forceinline__ void phase0(const Params& P, const Ctx& C) {
    LAS float* scr = (LAS float*)(C.lds + C.wave * 8448);
    const int gw = C.bid * 8 + C.wave, NGW = C.G * 8, lane = C.lane;
    conv_layer_items(P, C, 0, 0, 18688, gw, NGW);
    conv_layer_items(P, C, 0, 18688, 21760, gw, NGW);
    conv_layer_items(P, C, 0, 25856, CONV_ITEMS, gw, NGW);
    for (int it = gw; it < 64; it += NGW) {
        if (it < 32) { const int kb = it / 2, nb = it - kb * 2;
            tr_item(P.in[20], 64, 32 * nb, nullptr, 64 * kb, WSP(bf16_t, WS_V1T), 1024, 32 * nb, scr, lane); }
        else { const int nb = it - 32;
            tr_item(P.in[21], 1024, 32 * nb, nullptr, 0, WSP(bf16_t, WS_V2T), 64, 32 * nb, scr, lane); }
    }
    for (int m = gw; m < M; m += NGW) {
        const float* xr = (m < MP) ? P.in[0] + (size_t)m * 2048 : P.in[1] + (size_t)(m - MP) * 2048;
        bf16_t* o = WSP(bf16_t, WS_XB) + (size_t)m * 2048; float s = 0.f; f32x4 xv[8];
#pragma unroll
        for (int j = 0; j < 8; ++j) xv[j] = *(const f32x4*)(xr + 4 * lane + 256 * j);
        __builtin_amdgcn_sched_barrier(0);
#pragma unroll
        for (int j = 0; j < 8; ++j) { const f32x4 v = xv[j]; s += (v[0] * v[0] + v[1] * v[1]) + (v[2] * v[2] + v[3] * v[3]);
            u32x2 w; w.x = pk2(v[0], v[1]); w.y = pk2(v[2], v[3]); *(u32x2*)(o + 4 * lane + 256 * j) = w; }
        s = wave_sum(s);
        if (lane == 0) WSP(float, WS_SS)[m] = s;
    }
    for (int r = gw; r < 2 * M; r += NGW) { const int l = r / M, m = r - l * M;
        const float* pr = (m < MP) ? P.in[6] + ((size_t)l * MP + m) * 256 : P.in[7] + ((size_t)l * 1024 + (m - MP)) * 256;
        const f32x4 v = *(const f32x4*)(pr + 4 * lane); u32x2 w; w.x = pk2(v[0], v[1]); w.y = pk2(v[2], v[3]);
        *(u32x2*)(WSP(bf16_t, WS_PB) + (size_t)r * 256 + 4 * lane) = w; }
    const int gt = C.bid * NTHREADS + C.tid, NGT = C.G * NTHREADS;
    for (int i = gt; i < 5 * M; i += NGT) WSP(float, WS_SS)[M + i] = 0.f;
    for (int i = gt; i < 2 * 1024 * 96; i += NGT) { const int l = i / (1024 * 96), r = i - l * 1024 * 96, n = r / 96, k = r - n * 96;
        WSP(bf16_t, WS_W2T)[i] = (bf16_t)(pk2(P.in[14][(size_t)l * 96 * 1024 + k * 1024 + n], 0.f) & 0xffff);
        WSP(bf16_t, WS_A2T)[i] = (bf16_t)(pk2(P.in[16][(size_t)l * 96 * 1024 + k * 1024 + n], 0.f) & 0xffff); }
    for (int i = gt; i < 2056 * 128; i += NGT) { const int pi = i >> 7, ii = i & 127; const int pos = pi < 2048 ? pi : 16384 + (pi - 2048);
        const float inv = exp2f(-(float)ii * (13.287712379549449f / 128.0f)); const float ang = (float)pos * inv;
        const double a = (double)ang; const double k = rint(a * 0.15915494309189535); const float rr = (float)(a - k * 6.283185307179586);
        f32x2 cs; cs.x = __cosf(rr); cs.y = __sinf(rr); WSP(f32x2, WS_ROPE)[i] = cs; }
}

__device__ __forceinline__ bool seq_first(int g) { return g < MP ? ((g & 2047) == 0) : (((g - MP) & 7) == 0); }
__device__ __forceinline__ void unpack8(const u32x4 q, float (&o)[8]) { o[0] = bflo(q.x); o[1] = bfhi(q.x); o[2] = bflo(q.y); o[3] = bfhi(q.y); o[4] = bflo(q.z); o[5] = bfhi(q.z); o[6] = bflo(q.w); o[7] = bfhi(q.w); }
__device__ __forceinline__ void mix8(const bf16_t* Z, int g, int zc, int oc, bool first, const float* srow, const float* mu, float (&o)[8]) {
    float cur[8], prv[8], sv[8];
    unpack8(*(const u32x4*)(Z + (size_t)g * NPAD + zc), cur);
    unpack8(*(const u32x4*)(Z + (size_t)(first ? g : g - 1) * NPAD + zc), prv);
    { const float* sp = srow ? srow : mu; const float sc = srow ? 1.f : 0.f; const f32x4 a = *(const f32x4*)(sp + oc) * sc, b = *(const f32x4*)(sp + oc + 4) * sc;
      sv[0] = a[0]; sv[1] = a[1]; sv[2] = a[2]; sv[3] = a[3]; sv[4] = b[0]; sv[5] = b[1]; sv[6] = b[2]; sv[7] = b[3]; }
    const f32x4 m0 = *(const f32x4*)(mu + oc), m1 = *(const f32x4*)(mu + oc + 4);
    const float mm[8] = {m0[0], m0[1], m0[2], m0[3], m1[0], m1[1], m1[2], m1[3]};
#pragma unroll
    for (int j = 0; j < 8; ++j) { const float pv = first ? sv[j] : prv[j]; o[j] = cur[j] + (pv - cur[j]) * mm[j]; }
}
struct Mix8Raw { u32x4 cur, prv; f32x4 sa, sb, m0, m1; };
template <bool SMP>
__device__ __forceinline__ Mix8Raw mix8_load(const bf16_t* Z, int g, int zc, int oc, bool first, const float* srow, const float* mu) {
    Mix8Raw r;
    r.cur = *(const u32x4*)(Z + (size_t)g * NPAD + zc); r.prv = *(const u32x4*)(Z + (size_t)(first ? g : g - 1) * NPAD + zc);
    if (SMP) { r.sa = *(const f32x4*)(srow + oc); r.sb = *(const f32x4*)(srow + oc + 4); } else { r.sa = (f32x4){0.f, 0.f, 0.f, 0.f}; r.sb = r.sa; }
    r.m0 = *(const f32x4*)(mu + oc); r.m1 = *(const f32x4*)(mu + oc + 4);
    return r;
}
__device__ __forceinline__ void mix8_calc(const Mix8Raw& r, bool first, bool has_srow, float (&o)[8]) {
    float cur[8], prv[8]; unpack8(r.cur, cur); unpack8(r.prv, prv);
    const float sc = has_srow ? 1.f : 0.f; const f32x4 a = r.sa * sc, b = r.sb * sc;
    const float sv[8] = {a[0], a[1], a[2], a[3], b[0], b[1], b[2], b[3]};
    const float mm[8] = {r.m0[0], r.m0[1], r.m0[2], r.m0[3], r.m1[0], r.m1[1], r.m1[2], r.m1[3]};
#pragma unroll
    for (int j = 0; j < 8; ++j) { const float pv = first ? sv[j] : prv[j]; o[j] = cur[j] + (pv - cur[j]) * mm[j]; }
}
__device__ __forceinline__ bf16x8 pack8(const float (&u)[8]) {
    u32x4 w; w.x = pk2(u[0], u[1]); w.y = pk2(u[2], u[3]); w.z = pk2(u[4], u[5]); w.w = pk2(u[6], u[7]);
    return __builtin_bit_cast(bf16x8, w);
}
__device__ __forceinline__ void unpack4(const u32x2 q, float (&o)[4]) { o[0] = bflo(q.x); o[1] = bfhi(q.x); o[2] = bflo(q.y); o[3] = bfhi(q.y); }
__device__ __forceinline__ u32x2 pack4(float a, float b, float c, float d) { u32x2 w; w.x = pk2(a, b); w.y = pk2(c, d); return w; }

template <int l, bool SMP>
__device__ __forceinline__ void p2a_item(const Params& P, const Ctx& C, int item) {
    int tid = C.tid; asm volatile("" : "+v"(tid)); const int lane = tid & 63, w = C.wave, c = lane & 15, tg = lane >> 4;
    const int g0 = item * 16;
    const bf16_t* Z = WSP(bf16_t, WS_Z);
    const float* mu = P.in[12] + (size_t)l * 3264;
    { const char* zb = (const char*)Z + (size_t)ZR * 2;
#pragma unroll
      for (int q = 0; q < 2; ++q) { const int i = tid + 512 * q, row = i / 51, ln = i - row * 51; int g = g0 - 1 + row; g = g < 0 ? 0 : g;
          if (i < 17 * 51) (void)*(const volatile unsigned*)(zb + (size_t)g * (NPAD * 2) + ln * 128); }
      if (l == 1) { const int row = tid >> 5, ln = tid & 31; (void)*(const volatile unsigned*)((const char*)WSP(bf16_t, WS_VB) + (size_t)(g0 + (row & 15)) * 2048 + (ln & 15) * 128); } }
    bf16x8 Aw[3], Aa[3], At[2];
    {
        const int g = g0 + c; const bool first = seq_first(g);
        const float* srow = (g < MP) ? nullptr : P.in[4] + ((size_t)l * 128 + ((g - MP) >> 3)) * 3264;
        { Mix8Raw rw[3], ra[3];
#pragma unroll
          for (int ks = 0; ks < 3; ++ks) { rw[ks] = mix8_load<SMP>(Z, g, ZWL + 32 * ks + 8 * tg, 1024 + 32 * ks + 8 * tg, first, srow, mu); ra[ks] = mix8_load<SMP>(Z, g, ZAL + 32 * ks + 8 * tg, 3168 + 32 * ks + 8 * tg, first, srow, mu); }
          __builtin_amdgcn_sched_barrier(0);
#pragma unroll
          for (int ks = 0; ks < 3; ++ks) { float u[8];
            mix8_calc(rw[ks], first, SMP, u);
#pragma unroll
            for (int j = 0; j < 8; ++j) { const float e = __expf(2.f * u[j]); u[j] = 1.f - 2.f * rcpf_(e + 1.f); }
            Aw[ks] = pack8(u);
            mix8_calc(ra[ks], first, SMP, u);
            Aa[ks] = pack8(u); } }
        if (l == 1) {
            f32x4 pv[4];
#pragma unroll
            for (int nt = 0; nt < 4; ++nt) pv[nt] = (f32x4){0.f, 0.f, 0.f, 0.f};
            const bf16_t* V1T = WSP(bf16_t, WS_V1T);
#pragma unroll
            for (int kp = 0; kp < 2; ++kp) { bf16x8 va[2], vbf[2][4]; Mix8Raw rv[2];
#pragma unroll
                for (int k2 = 0; k2 < 2; ++k2) { const int kc = 128 * w + 32 * (2 * kp + k2) + 8 * tg;
                    rv[k2] = mix8_load<SMP>(Z, g, ZV + kc, 2144 + kc, first, srow, mu);
#pragma unroll
                    for (int nt = 0; nt < 4; ++nt) vbf[k2][nt] = *(const bf16x8*)(V1T + (size_t)(16 * nt + c) * 1024 + kc); }
                __builtin_amdgcn_sched_barrier(0);
#pragma unroll
                for (int k2 = 0; k2 < 2; ++k2) { float u[8]; mix8_calc(rv[k2], first, SMP, u); va[k2] = pack8(u); }
#pragma unroll
                for (int k2 = 0; k2 < 2; ++k2)
#pragma unroll
                    for (int nt = 0; nt < 4; ++nt) pv[nt] = MFMA16(va[k2], vbf[k2][nt], pv[nt]); }
            LAS float* part = (LAS float*)C.lds;
#pragma unroll
            for (int nt = 0; nt < 4; ++nt)
#pragma unroll
                for (int i = 0; i < 4; ++i) part[(w * 16 + 4 * tg + i) * 64 + 16 * nt + c] = pv[nt][i];
            __syncthreads();
            { const int tok = tid >> 5, n2 = (tid & 31) * 2; float s0 = 0.f, s1 = 0.f;
#pragma unroll
                for (int ww = 0; ww < 8; ++ww) { const f32x2 v = *(const LAS f32x2*)(part + (ww * 16 + tok) * 64 + n2); s0 += v.x; s1 += v.y; }
                *(LAS unsigned*)(C.lds + 32768 + (tok * 64 + n2) * 2) = pk2(s0, s1); }
            __syncthreads();
#pragma unroll
            for (int ks = 0; ks < 2; ++ks) At[ks] = *(const LAS bf16x8*)(C.lds + 32768 + (c * 64 + 32 * ks + 8 * tg) * 2);
        }
    }
    const bf16_t* W2T = WSP(bf16_t, WS_W2T) + (size_t)l * 1024 * 96;
    const bf16_t* A2T = WSP(bf16_t, WS_A2T) + (size_t)l * 1024 * 96;
    const bf16_t* V2T = WSP(bf16_t, WS_V2T);
    const int gt = g0 + 4 * tg; const bool f4 = seq_first(gt);
    const float* srow4 = (gt < MP) ? nullptr : P.in[4] + ((size_t)l * 128 + ((gt - MP) >> 3)) * 3264;
#pragma unroll 1
    for (int hh = 0; hh < 2; ++hh) {
        const int hd = 2 * w + hh, ch0 = 64 * hd + 4 * c;
        f32x4 aw[4], aa[4], vl[4];
        {
            bf16x8 bw[4][3], ba[4][3], bv[4][2];
#pragma unroll
            for (int q = 0; q < 4; ++q) {
#pragma unroll
                for (int ks = 0; ks < 3; ++ks) { bw[q][ks] = *(const bf16x8*)(W2T + (size_t)(ch0 + q) * 96 + 32 * ks + 8 * tg); ba[q][ks] = *(const bf16x8*)(A2T + (size_t)(ch0 + q) * 96 + 32 * ks + 8 * tg); }
                if (l == 1) {
#pragma unroll
                    for (int ks = 0; ks < 2; ++ks) bv[q][ks] = *(const bf16x8*)(V2T + (size_t)(ch0 + q) * 64 + 32 * ks + 8 * tg); } }
            __builtin_amdgcn_sched_barrier(0);
#pragma unroll
            for (int q = 0; q < 4; ++q) { aw[q] = (f32x4){0.f, 0.f, 0.f, 0.f}; aa[q] = aw[q]; vl[q] = aw[q];
#pragma unroll
                for (int ks = 0; ks < 3; ++ks) { aw[q] = MFMA16(Aw[ks], bw[q][ks], aw[q]); aa[q] = MFMA16(Aa[ks], ba[q][ks], aa[q]); }
                if (l == 1) {
#pragma unroll
                    for (int ks = 0; ks < 2; ++ks) vl[q] = MFMA16(At[ks], bv[q][ks], vl[q]); } }
        }
        const f32x4 mur = *(const f32x4*)(mu + ch0), muk = *(const f32x4*)(mu + 1120 + ch0), muv = *(const f32x4*)(mu + 2144 + ch0);
        const f32x4 w0 = *(const f32x4*)(P.in[13] + l * 1024 + ch0), a0 = *(const f32x4*)(P.in[15] + l * 1024 + ch0);
        const f32x4 kkc = *(const f32x4*)(P.in[17] + l * 1024 + ch0), kac = *(const f32x4*)(P.in[18] + l * 1024 + ch0), rkc = *(const f32x4*)(P.in[22] + l * 1024 + ch0);
        f32x4 v0c = (f32x4){0.f, 0.f, 0.f, 0.f}; if (l == 1) v0c = *(const f32x4*)(P.in[19] + ch0);
        float pr[4], pk[4], pvv[4];
        { const bf16_t* zp = Z + (size_t)(f4 ? gt : gt - 1) * NPAD + ch0; float zr_[4], zk_[4], zv_[4];
          unpack4(*(const u32x2*)(zp + ZR), zr_); unpack4(*(const u32x2*)(zp + ZK), zk_); unpack4(*(const u32x2*)(zp + ZV), zv_);
          f32x4 sa = (f32x4){0.f, 0.f, 0.f, 0.f}, sb = sa, sd = sa;
          if (SMP) { sa = *(const f32x4*)(srow4 + ch0); sb = *(const f32x4*)(srow4 + 1120 + ch0); sd = *(const f32x4*)(srow4 + 2144 + ch0); }
#pragma unroll
          for (int q = 0; q < 4; ++q) { pr[q] = f4 ? sa[q] : zr_[q]; pk[q] = f4 ? sb[q] : zk_[q]; pvv[q] = f4 ? sd[q] : zv_[q]; } }
        u32x2 zrw[4], zkw[4], zvw[4], vfw[4];
        constexpr int NPRE = (l == 0) ? 4 : 2;
#pragma unroll
        for (int i = 0; i < 4; ++i) {
            if (i % NPRE == 0) {
#pragma unroll
                for (int ii = i; ii < i + NPRE; ++ii) { const bf16_t* zrow = Z + (size_t)(gt + ii) * NPAD + ch0; zrw[ii] = *(const u32x2*)(zrow + ZR); zkw[ii] = *(const u32x2*)(zrow + ZK); zvw[ii] = *(const u32x2*)(zrow + ZV);
                    vfw[ii] = (u32x2){0u, 0u}; if (l == 1) vfw[ii] = *(const u32x2*)(WSP(bf16_t, WS_VB) + (size_t)(gt + ii) * 1024 + ch0); } }
            const int g = gt + i; const size_t eo = (size_t)g * 1024 + ch0;
            float cr[4], ck[4], cv[4], vf[4];
            unpack4(zrw[i], cr); unpack4(zkw[i], ck); unpack4(zvw[i], cv);
            if (l == 1) unpack4(vfw[i], vf);
            float r[4], k[4], v[4], a[4], kkr[4], kp[4]; f32x4 dw; float ss = 0.f, bon = 0.f;
#pragma unroll
            for (int q = 0; q < 4; ++q) {
                r[q] = cr[q] + (pr[q] - cr[q]) * mur[q]; k[q] = ck[q] + (pk[q] - ck[q]) * muk[q]; v[q] = cv[q] + (pvv[q] - cv[q]) * muv[q];
                pr[q] = cr[q]; pk[q] = ck[q]; pvv[q] = cv[q];
                const float wl = w0[q] + aw[q][i]; dw[q] = __expf(-0.6065306597126334f * sigm(wl));
                a[q] = sigm(a0[q] + aa[q][i]);
                kkr[q] = k[q] * kkc[q]; ss += kkr[q] * kkr[q];
                kp[q] = k[q] * (1.f + (a[q] - 1.f) * kac[q]);
                if (l == 1) v[q] = v[q] + (vf[q] - v[q]) * sigm(v0c[q] + vl[q][i]);
                bon += r[q] * kp[q] * rkc[q];
            }
            ss = red16(ss); bon = red16(bon);
            const float inv = __builtin_amdgcn_rsqf(fmaxf(ss, 1e-24f));
            float kk[4];
#pragma unroll
            for (int q = 0; q < 4; ++q) kk[q] = kkr[q] * inv;
            *(f32x4*)(WSP(float, WS_DW) + eo) = dw;
            *(u32x2*)(WSP(bf16_t, WS_R) + eo) = pack4(r[0], r[1], r[2], r[3]);
            *(u32x2*)(WSP(bf16_t, WS_KK) + eo) = pack4(kk[0], kk[1], kk[2], kk[3]);
            *(u32x2*)(WSP(bf16_t, WS_BB) + eo) = pack4(kk[0] * a[0], kk[1] * a[1], kk[2] * a[2], kk[3] * a[3]);
            *(u32x2*)(WSP(bf16_t, WS_KP) + eo) = pack4(kp[0], kp[1], kp[2], kp[3]);
            *(u32x2*)(WSP(bf16_t, WS_VB) + (size_t)l * M * 1024 + eo) = pack4(v[0], v[1], v[2], v[3]);
            if (c == 0) WSP(float, WS_BONUS)[(size_t)g * 16 + hd] = bon;
        }
    }
    {
        const bool prompt = g0 < MP;
        const int nlast = prompt ? (((g0 + 16) & 2047) == 0 ? 1 : 0) : 2;
        for (int q = 0; q < nlast; ++q) {
            const int g = prompt ? g0 + 15 : g0 + 7 + 8 * q;
            float* o = prompt ? C.out + OFF_SHP + ((size_t)l * 4 + (g >> 11)) * 3264 : C.out + OFF_SHS + ((size_t)l * 128 + ((g - MP) >> 3)) * 3264;
            for (int oc = tid; oc < 3264; oc += NTHREADS) {
                const int zc = oc < 1024 ? ZR + oc : oc < 1120 ? ZWL + (oc - 1024) : oc < 2144 ? ZK + (oc - 1120) : oc < 3168 ? ZV + (oc - 2144) : ZAL + (oc - 3168);
                o[oc] = bf2f(Z[(size_t)g * NPAD + zc]); }
        }
    }
    if (l == 1) __syncthreads();
}

struct SeqInfo { int base, T, b; bool prompt; };
__device__ __forceinline__ SeqInfo seq_info(int sq) { SeqInfo s; s.prompt = sq < 4; s.b = s.prompt ? sq : sq - 4; s.base = s.prompt ? sq * 2048 : MP + (sq - 4) * 8; s.T = s.prompt ? 2048 : 8; return s; }

constexpr int RO_AT = 0, RO_RH = 2304, RO_BK = 4608, RO_M1 = 8704, RO_BKR = 9728, RO_VT = 10752, RO_GC = 12800;
__device__ __forceinline__ f32x4 mm16f(const LAS float* A, const LAS float* B, f32x4 acc, int fr, int fq) {
#pragma unroll
    for (int kk = 0; kk < 4; ++kk) acc = __builtin_amdgcn_mfma_f32_16x16x4f32(A[fr * 16 + 4 * kk + fq], B[(4 * kk + fq) * 16 + fr], acc, 0, 0, 0);
    return acc;
}
__device__ __forceinline__ void st16f(LAS float* D, const f32x4 acc, int fr, int fq) {
#pragma unroll
    for (int r = 0; r < 4; ++r) D[(4 * fq + r) * 16 + fr] = acc[r];
}
__device__ __forceinline__ void rwkv_prep_item(const Params& P, const Ctx& C, int l, int item, LAS unsigned char* wl, int lane) {
    const int hd = item / 640, gc = item - hd * 640;
    const int base = gc < 512 ? (gc >> 7) * 2048 + 16 * (gc & 127) : MP + 8 * (gc - 512);
    const int nvalid = gc < 512 ? 16 : 8;
    unsigned char* rec = C.ws + WS_RWP + (size_t)item * RWREC;
    const float* DW = WSP(float, WS_DW); const bf16_t* R = WSP(bf16_t, WS_R); const bf16_t* KK = WSP(bf16_t, WS_KK); const bf16_t* BB = WSP(bf16_t, WS_BB);
    const bf16_t* KP = WSP(bf16_t, WS_KP); const bf16_t* VB = WSP(bf16_t, WS_VB) + (size_t)l * M * 1024;
    constexpr int AH = 0, RH = 2304, BH = 4608, KH = 6912, NB = 9216, XB = 10240, PBF = 11264, AKB = 12288;
    const int fr = lane & 15, fq = lane >> 4;
    float g = 1.f; float bh[16], kh[16]; unsigned vp[8]; unsigned rhp[8];
    float dv[16]; unsigned kkv[16], bbv[16], kpv[16], rv[16], vv[16];
#pragma unroll
    for (int t = 0; t < 16; ++t) { const size_t o = (size_t)(base + (t < nvalid ? t : nvalid - 1)) * 1024 + hd * 64 + lane;
        dv[t] = DW[o]; kkv[t] = KK[o]; bbv[t] = BB[o]; kpv[t] = KP[o]; rv[t] = R[o]; vv[t] = VB[o]; }
    __builtin_amdgcn_sched_barrier(0);
#pragma unroll
    for (int t = 0; t < 16; ++t) {
        const bool ok = t < nvalid;
        const float d = ok ? dv[t] : 1.f, kk = ok ? bf2f((bf16_t)kkv[t]) : 0.f, bb = ok ? bf2f((bf16_t)bbv[t]) : 0.f, kp = ok ? bf2f((bf16_t)kpv[t]) : 0.f, r = ok ? bf2f((bf16_t)rv[t]) : 0.f;
        const unsigned vbits = ok ? vv[t] : 0u;
        const float ah = -kk * g; g *= d; const float ig = rcpf_(g);
        bh[t] = bb * ig; kh[t] = kp * ig;
        const unsigned pa = pk2(ah, r * g), pb = pk2(bh[t], kh[t]);
        *(LAS bf16_t*)(wl + AH + t * 144 + lane * 2) = (bf16_t)(pa & 0xffff);
        *(LAS bf16_t*)(wl + RH + t * 144 + lane * 2) = (bf16_t)(pa >> 16);
        *(LAS bf16_t*)(wl + BH + t * 144 + lane * 2) = (bf16_t)(pb & 0xffff);
        *(LAS bf16_t*)(wl + KH + t * 144 + lane * 2) = (bf16_t)(pb >> 16);
        if (t & 1) { vp[t >> 1] |= vbits << 16; rhp[t >> 1] |= pa & 0xffff0000u; } else { vp[t >> 1] = vbits; rhp[t >> 1] = pa >> 16; }
    }
#pragma unroll
    for (int t = 0; t < 16; ++t) *(bf16_t*)(rec + RO_RH + t * 144 + lane * 2) = (bf16_t)((t & 1) ? (rhp[t >> 1] >> 16) : (rhp[t >> 1] & 0xffff));
    *(float*)(rec + RO_GC + lane * 4) = g;
    { u32x4 w0, w1, w2, w3;
      w0.x = pk2(bh[0] * g, bh[1] * g); w0.y = pk2(bh[2] * g, bh[3] * g); w0.z = pk2(bh[4] * g, bh[5] * g); w0.w = pk2(bh[6] * g, bh[7] * g);
      w1.x = pk2(bh[8] * g, bh[9] * g); w1.y = pk2(bh[10] * g, bh[11] * g); w1.z = pk2(bh[12] * g, bh[13] * g); w1.w = pk2(bh[14] * g, bh[15] * g);
      w2.x = pk2(kh[0] * g, kh[1] * g); w2.y = pk2(kh[2] * g, kh[3] * g); w2.z = pk2(kh[4] * g, kh[5] * g); w2.w = pk2(kh[6] * g, kh[7] * g);
      w3.x = pk2(kh[8] * g, kh[9] * g); w3.y = pk2(kh[10] * g, kh[11] * g); w3.z = pk2(kh[12] * g, kh[13] * g); w3.w = pk2(kh[14] * g, kh[15] * g);
      u32x4* bk = (u32x4*)(rec + RO_BK + lane * 64); bk[0] = w0; bk[1] = w1; bk[2] = w2; bk[3] = w3;
      u32x4 v0, v1; v0.x = vp[0]; v0.y = vp[1]; v0.z = vp[2]; v0.w = vp[3]; v1.x = vp[4]; v1.y = vp[5]; v1.z = vp[6]; v1.w = vp[7];
      u32x4* vt = (u32x4*)(rec + RO_VT + lane * 32); vt[0] = v0; vt[1] = v1; }
    LDS_WAIT();
    f32x4 aN = (f32x4){0.f, 0.f, 0.f, 0.f}, aAK = aN, aBR = aN, aKR = aN;
#pragma unroll
    for (int ks = 0; ks < 2; ++ks) { const int ko = (32 * ks + 8 * fq) * 2;
        const bf16x8 fb = ldfrag(wl, BH + fr * 144 + ko), fk = ldfrag(wl, KH + fr * 144 + ko), fa = ldfrag(wl, AH + fr * 144 + ko), frr = ldfrag(wl, RH + fr * 144 + ko);
        aN = MFMA16(fb, fa, aN); aAK = MFMA16(fk, fa, aAK); aBR = MFMA16(fb, frr, aBR); aKR = MFMA16(fk, frr, aKR); }
    f32x4 pacc;
#pragma unroll
    for (int r = 0; r < 4; ++r) { const int sidx = 4 * fq + r;
        if (sidx >= fr) { aN[r] = 0.f; aAK[r] = 0.f; }
        if (sidx > fr) { aBR[r] = 0.f; aKR[r] = 0.f; }
        pacc[r] = aN[r] + (sidx == fr ? 1.f : 0.f); }
    *(u32x2*)(rec + RO_BKR + fr * 64 + 8 * fq) = pack4(aBR[0], aBR[1], aBR[2], aBR[3]);
    *(u32x2*)(rec + RO_BKR + fr * 64 + 32 + 8 * fq) = pack4(aKR[0], aKR[1], aKR[2], aKR[3]);
    LAS float* Nb = (LAS float*)(wl + NB); LAS float* Xb = (LAS float*)(wl + XB); LAS float* Pb = (LAS float*)(wl + PBF); LAS float* AKb = (LAS float*)(wl + AKB);
    st16f(Nb, aN, fr, fq); st16f(Pb, pacc, fr, fq); st16f(AKb, aAK, fr, fq);
    LDS_WAIT();
    const f32x4 z4 = (f32x4){0.f, 0.f, 0.f, 0.f};
    f32x4 x = mm16f(Nb, Nb, z4, fr, fq); st16f(Xb, x, fr, fq); LDS_WAIT();
    pacc = mm16f(Pb, Xb, pacc, fr, fq); LDS_WAIT(); st16f(Pb, pacc, fr, fq);
    x = mm16f(Xb, Xb, z4, fr, fq); LDS_WAIT(); st16f(Nb, x, fr, fq); LDS_WAIT();
    pacc = mm16f(Pb, Nb, pacc, fr, fq); LDS_WAIT(); st16f(Pb, pacc, fr, fq);
    x = mm16f(Nb, Nb, z4, fr, fq); LDS_WAIT(); st16f(Xb, x, fr, fq); LDS_WAIT();
    pacc = mm16f(Pb, Xb, pacc, fr, fq); LDS_WAIT(); st16f(Pb, pacc, fr, fq); LDS_WAIT();
#pragma unroll
    for (int jt = 0; jt < 4; ++jt) { f32x4 acc = z4;
#pragma unroll
        for (int kk = 0; kk < 4; ++kk) { const float a = bf2f(*(const LAS bf16_t*)(wl + AH + (4 * kk + fq) * 144 + (16 * jt + fr) * 2)); acc = __builtin_amdgcn_mfma_f32_16x16x4f32(a, Pb[(4 * kk + fq) * 16 + fr], acc, 0, 0, 0); }
        *(u32x2*)(rec + RO_AT + fr * 144 + (16 * jt + 4 * fq) * 2) = pack4(acc[0], acc[1], acc[2], acc[3]); }
    { const f32x4 acc = mm16f(AKb, Pb, z4, fr, fq);
      *(u32x2*)(rec + RO_M1 + fr * 64 + 8 * fq) = (u32x2){0u, 0u};
      *(u32x2*)(rec + RO_M1 + fr * 64 + 32 + 8 * fq) = pack4(acc[0], acc[1], acc[2], acc[3]); }
    LDS_WAIT();
}
__device__ __forceinline__ void phase2b(const Params& P, const Ctx& C, int l) {
    int lane = C.lane; asm volatile("" : "+v"(lane));
    LAS unsigned char* wl = C.lds + C.wave * 13312;
    const int gw = C.wave * C.G + C.bid, NGW = C.G * 8;
    for (int item = gw; item < 10240; item += NGW) rwkv_prep_item(P, C, l, item, wl, lane);
}
__device__ __forceinline__ void rwkv_task(const Params& P, const Ctx& C, int l, int sq, int hd) {
    int tid = C.tid; asm volatile("" : "+v"(tid)); const SeqInfo si = seq_info(sq); const int lane = tid & 63, w = C.wave, fr = lane & 15, fq = lane >> 4;
    LAS unsigned char* lds = C.lds;
    constexpr int REC0 = 0, BATCH = 4 * (int)RWREC, S0B = 2 * BATCH, UVB = S0B + 9216;
    const float* S0 = si.prompt ? nullptr : P.in[3] + (((size_t)l * 128 + si.b) * 16 + hd) * 4096;
    float* Sout = si.prompt ? C.out + OFF_RWP + (((size_t)l * 4 + si.b) * 16 + hd) * 4096 : C.out + OFF_RWS + (((size_t)l * 128 + si.b) * 16 + hd) * 4096;
    bf16_t* YRW = WSP(bf16_t, WS_YRW);
    const int nchunk = si.prompt ? 128 : 1, gc0 = si.prompt ? sq * 128 : 512 + (sq - 4);
    const unsigned char* recg = C.ws + WS_RWP + (size_t)(hd * 640 + gc0) * RWREC;
    const int it = w;
    f32x4 sacc[4];
    if (w < 4) {
#pragma unroll
        for (int jt = 0; jt < 4; ++jt) { sacc[jt] = S0 ? *(const f32x4*)(S0 + (size_t)(16 * it + fr) * 64 + 16 * jt + 4 * fq) : (f32x4){0.f, 0.f, 0.f, 0.f};
            *(LAS u32x2*)(lds + S0B + (16 * it + fr) * 144 + (16 * jt + 4 * fq) * 2) = pack4(sacc[jt][0], sacc[jt][1], sacc[jt][2], sacc[jt][3]); }
        *(LAS u32x2*)(lds + UVB + (16 * it + fr) * 32 + 8 * fq) = (u32x2){0u, 0u};
    }
    const int nb = (nchunk + 3) >> 2;
    const int tl = tid - 256;
    u32x4 ra[13], rb[13];
#define RW_NP(bi) (((nchunk - 4 * (bi)) < 4 ? (nchunk - 4 * (bi)) : 4) * (int)(RWREC / 16))
#define RW_GLOAD(R, bi) do { const int np_ = RW_NP(bi); const u32x4* src_ = (const u32x4*)(recg + (size_t)(bi) * BATCH); _Pragma("unroll") for (int q = 0; q < 13; ++q) { const int pi = tl + 256 * q; R[q] = src_[pi < np_ ? pi : np_ - 1]; } } while (0)
#define RW_LWRITE(R, bi) do { const int np_ = RW_NP(bi); LAS u32x4* dst_ = (LAS u32x4*)(lds + REC0 + ((bi) & 1) * BATCH); _Pragma("unroll") for (int q = 0; q < 13; ++q) { const int pi = tl + 256 * q; if (pi < np_) dst_[pi] = R[q]; } } while (0)
    if (w >= 4) {
        RW_GLOAD(ra, 0); if (nb > 1) RW_GLOAD(rb, 1); RW_LWRITE(ra, 0);
        __syncthreads();
        for (int bi = 0; bi < nb; ++bi) {
            if ((bi & 1) == 0) { if (bi + 2 < nb) RW_GLOAD(ra, bi + 2); if (bi + 1 < nb) RW_LWRITE(rb, bi + 1); }
            else               { if (bi + 2 < nb) RW_GLOAD(rb, bi + 2); if (bi + 1 < nb) RW_LWRITE(ra, bi + 1); }
            __syncthreads();
        }
    } else {
        __syncthreads();
        const int so = S0B + (16 * it + fr) * 144, uo = UVB + (16 * it + fr) * 32;
        for (int bi = 0; bi < nb; ++bi) {
            const int ncb = (nchunk - 4 * bi) < 4 ? (nchunk - 4 * bi) : 4;
            for (int c = 0; c < ncb; ++c) {
                const LAS unsigned char* rec = lds + REC0 + (bi & 1) * BATCH + c * (int)RWREC;
                const bf16x8 at0 = ldfrag(rec, RO_AT + fr * 144 + 16 * fq), at1 = ldfrag(rec, RO_AT + fr * 144 + 64 + 16 * fq);
                const bf16x8 s0 = ldfrag(lds, so + 16 * fq), s1 = ldfrag(lds, so + 64 + 16 * fq);
                const bf16x8 m1 = ldfrag(rec, RO_M1 + fr * 64 + fq * 16), vfrag = ldfrag(rec, RO_VT + (16 * it + fr) * 32 + (fq & 1) * 16), uold = ldfrag(lds, uo + (fq & 1) * 16);
                const bf16x8 rh0 = ldfrag(rec, RO_RH + fr * 144 + 16 * fq), rh1 = ldfrag(rec, RO_RH + fr * 144 + 64 + 16 * fq), bkr = ldfrag(rec, RO_BKR + fr * 64 + fq * 16);
                bf16x8 bk[4]; f32x4 g4[4];
#pragma unroll
                for (int jt = 0; jt < 4; ++jt) { bk[jt] = ldfrag(rec, RO_BK + (16 * jt + fr) * 64 + fq * 16); g4[jt] = *(const LAS f32x4*)(rec + RO_GC + (16 * jt + 4 * fq) * 4); }
                __builtin_amdgcn_sched_barrier(0);
                f32x4 au = (f32x4){0.f, 0.f, 0.f, 0.f};
                au = MFMA16(at0, s0, au); au = MFMA16(at1, s1, au); au = MFMA16(m1, fq < 2 ? uold : vfrag, au);
                f32x4 ay = (f32x4){0.f, 0.f, 0.f, 0.f};
                ay = MFMA16(s0, rh0, ay); ay = MFMA16(s1, rh1, ay);
#pragma unroll
                for (int jt = 0; jt < 4; ++jt) sacc[jt] *= g4[jt];
                asm volatile("" ::: "memory");
                *(LAS u32x2*)(lds + uo + 8 * fq) = pack4(au[0], au[1], au[2], au[3]);
                asm volatile("" ::: "memory");
                const bf16x8 unew = ldfrag(lds, uo + (fq & 1) * 16);
                const bf16x8 uv = fq < 2 ? unew : vfrag;
#pragma unroll
                for (int jt = 0; jt < 4; ++jt) sacc[jt] = MFMA16(bk[jt], uv, sacc[jt]);
                ay = MFMA16(uv, bkr, ay);
#pragma unroll
                for (int jt = 0; jt < 4; ++jt) *(LAS u32x2*)(lds + so + (16 * jt + 4 * fq) * 2) = pack4(sacc[jt][0], sacc[jt][1], sacc[jt][2], sacc[jt][3]);
                const int tl = 16 * (4 * bi + c) + fr;
                if (tl < si.T) *(u32x2*)(YRW + (size_t)(si.base + tl) * 1024 + hd * 64 + 16 * it + 4 * fq) = pack4(ay[0], ay[1], ay[2], ay[3]);
                asm volatile("" ::: "memory");
            }
            __syncthreads();
        }
    }
#undef RW_NP
#undef RW_GLOAD
#undef RW_LWRITE
    if (w < 4) {
#pragma unroll
        for (int jt = 0; jt < 4; ++jt) *(f32x4*)(Sout + (size_t)(16 * it + fr) * 64 + 16 * jt + 4 * fq) = sacc[jt];
    }
}

__device__ __forceinline__ void rwkv_s_task(const Params& P, const Ctx& C, int l, int sq, int hq) {
    int tid = C.tid; asm volatile("" : "+v"(tid)); const SeqInfo si = seq_info(sq); const int lane = tid & 63, w = C.wave, fr = lane & 15, fq = lane >> 4;
    LAS unsigned char* lds = C.lds;
    constexpr int REC0 = 0, SLOT = 13056, S0B = 2 * SLOT, UVB = S0B + 9216;
    bf16_t* YRW = WSP(bf16_t, WS_YRW);
    const int gc = 512 + (sq - 4), it = w, tl = tid - 256;
    u32x4 rr[4];
#define RS_GLOAD(hd_) do { const u32x4* src_ = (const u32x4*)(C.ws + WS_RWP + (size_t)((hd_) * 640 + gc) * RWREC); _Pragma("unroll") for (int q = 0; q < 4; ++q) { const int pi = tl + 256 * q; rr[q] = src_[pi < 816 ? pi : 815]; } } while (0)
#define RS_LWRITE(slot_) do { LAS u32x4* dst_ = (LAS u32x4*)(lds + REC0 + (slot_) * SLOT); _Pragma("unroll") for (int q = 0; q < 4; ++q) { const int pi = tl + 256 * q; if (pi < 816) dst_[pi] = rr[q]; } } while (0)
    f32x4 nxt[4];
    if (w >= 4) { RS_GLOAD(4 * hq); RS_LWRITE(0); }
    else {
        const float* S0 = P.in[3] + (((size_t)l * 128 + si.b) * 16 + 4 * hq) * 4096;
#pragma unroll
        for (int jt = 0; jt < 4; ++jt) nxt[jt] = *(const f32x4*)(S0 + (size_t)(16 * it + fr) * 64 + 16 * jt + 4 * fq);
        *(LAS u32x2*)(lds + UVB + (16 * it + fr) * 32 + 8 * fq) = (u32x2){0u, 0u};
    }
    __syncthreads();
#pragma unroll 1
    for (int hh0 = 0; hh0 < 4; ++hh0) {
        int hh = hh0; asm volatile("" : "+s"(hh));
        const int hd = 4 * hq + hh;
        if (w >= 4) { if (hh < 3) { RS_GLOAD(hd + 1); RS_LWRITE((hh + 1) & 1); } }
        else {
            f32x4 sacc[4];
#pragma unroll
            for (int jt = 0; jt < 4; ++jt) { sacc[jt] = nxt[jt];
                *(LAS u32x2*)(lds + S0B + (16 * it + fr) * 144 + (16 * jt + 4 * fq) * 2) = pack4(sacc[jt][0], sacc[jt][1], sacc[jt][2], sacc[jt][3]); }
            if (hh < 3) { const float* S1 = P.in[3] + (((size_t)l * 128 + si.b) * 16 + hd + 1) * 4096;
#pragma unroll
                for (int jt = 0; jt < 4; ++jt) nxt[jt] = *(const f32x4*)(S1 + (size_t)(16 * it + fr) * 64 + 16 * jt + 4 * fq); }
            const LAS unsigned char* rec = lds + REC0 + (hh & 1) * SLOT;
            const int so = S0B + (16 * it + fr) * 144, uo = UVB + (16 * it + fr) * 32;
            f32x4 au = (f32x4){0.f, 0.f, 0.f, 0.f};
#pragma unroll
            for (int ks = 0; ks < 2; ++ks) au = MFMA16(ldfrag(rec, RO_AT + fr * 144 + (32 * ks + 8 * fq) * 2), ldfrag(lds, so + (32 * ks + 8 * fq) * 2), au);
            const bf16x8 vfrag = ldfrag(rec, RO_VT + (16 * it + fr) * 32 + (fq & 1) * 16);
            { const bf16x8 uold = ldfrag(lds, uo + (fq & 1) * 16); au = MFMA16(ldfrag(rec, RO_M1 + fr * 64 + fq * 16), fq < 2 ? uold : vfrag, au); }
            asm volatile("" ::: "memory");
            *(LAS u32x2*)(lds + uo + 8 * fq) = pack4(au[0], au[1], au[2], au[3]);
            asm volatile("" ::: "memory");
            const bf16x8 unew = ldfrag(lds, uo + (fq & 1) * 16);
            const bf16x8 uv = fq < 2 ? unew : vfrag;
            f32x4 ay = (f32x4){0.f, 0.f, 0.f, 0.f};
#pragma unroll
            for (int ks = 0; ks < 2; ++ks) ay = MFMA16(ldfrag(lds, so + (32 * ks + 8 * fq) * 2), ldfrag(rec, RO_RH + fr * 144 + (32 * ks + 8 * fq) * 2), ay);
            ay = MFMA16(uv, ldfrag(rec, RO_BKR + fr * 64 + fq * 16), ay);
            if (fr < si.T) *(u32x2*)(YRW + (size_t)(si.base + fr) * 1024 + hd * 64 + 16 * it + 4 * fq) = pack4(ay[0], ay[1], ay[2], ay[3]);
            float* Sout = C.out + OFF_RWS + (((size_t)l * 128 + si.b) * 16 + hd) * 4096;
#pragma unroll
            for (int jt = 0; jt < 4; ++jt) { const f32x4 g4 = *(const LAS f32x4*)(rec + RO_GC + (16 * jt + 4 * fq) * 4); sacc[jt] *= g4;
                sacc[jt] = MFMA16(ldfrag(rec, RO_BK + (16 * jt + fr) * 64 + fq * 16), uv, sacc[jt]);
                *(f32x4*)(Sout + (size_t)(16 * it + fr) * 64 + 16 * jt + 4 * fq) = sacc[jt]; }
        }
        __syncthreads();
    }
#undef RS_GLOAD
#undef RS_LWRITE
}
constexpr int HQA = 0, HQS = 17408, HKD = 34816, HKST = 52224, HVT = 70656, HPB = 89088, HST = 98304, HSEG = 133120, HEBL = 137216;
constexpr size_t HREC = 50688;
__device__ __forceinline__ void hgrn_stage_att(const Params& P, const Ctx& C, int l, const SeqInfo& si, int h, int n, int nti, int tid, int w, int fr, int fq) {
    LAS unsigned char* lds = C.lds; const bf16_t* Z = WSP(bf16_t, WS_Z);
    const int k2 = tid & 63, seg = tid >> 6;
    float lb0 = 0.f, lb1 = 0.f;
    if (l == 1) { const float* hl = P.in[10]; const int cc = h * 128 + 2 * k2; lb0 = sigm(hl[1024 + cc] - hl[cc]); lb1 = sigm(hl[1024 + cc + 1] - hl[cc + 1]); }
    float lf[8][2], kk[8][2], qq[8][2], vv[8][2];
#pragma unroll
    for (int j = 0; j < 8; ++j) { lf[j][0] = lf[j][1] = 0.f; kk[j][0] = kk[j][1] = 0.f; qq[j][0] = qq[j][1] = 0.f; vv[j][0] = vv[j][1] = 0.f; }
    if (64 * n + 8 * seg < si.T) {
      unsigned zq[8], zf[8], zi[8];
#pragma unroll
      for (int j = 0; j < 8; ++j) { const bf16_t* zr = Z + (size_t)(si.base + 64 * n + 8 * seg + j) * NPAD + h * 128 + 2 * k2; zq[j] = *(const unsigned*)(zr + ZHQ); zf[j] = *(const unsigned*)(zr + ZHF); zi[j] = *(const unsigned*)(zr + ZHI); }
      __builtin_amdgcn_sched_barrier(0);
#pragma unroll
      for (int j = 0; j < 8; ++j) { const unsigned hq = zq[j], hf = zf[j], hi = zi[j];
        { const float sg = sigm(bflo(hf)); const float f = lb0 + (1.f - lb0) * sg; lf[j][0] = __logf(fmaxf(f, 1e-30f)); kk[j][0] = (1.f - lb0) * (1.f - sg); qq[j][0] = siluf(bflo(hq)) * 0.08838834764831845f; vv[j][0] = bflo(hi); }
        { const float sg = sigm(bfhi(hf)); const float f = lb1 + (1.f - lb1) * sg; lf[j][1] = __logf(fmaxf(f, 1e-30f)); kk[j][1] = (1.f - lb1) * (1.f - sg); qq[j][1] = siluf(bfhi(hq)) * 0.08838834764831845f; vv[j][1] = bfhi(hi); } }
    }
#pragma unroll
    for (int j = 1; j < 8; ++j) { lf[j][0] += lf[j - 1][0]; lf[j][1] += lf[j - 1][1]; }
    *(LAS f32x2*)(lds + HSEG + (seg * 128 + 2 * k2) * 4) = (f32x2){lf[7][0], lf[7][1]};
    __syncthreads();
    float pre0 = 0.f, pre1 = 0.f, tot0 = 0.f, tot1 = 0.f, r10 = 0.f, r11 = 0.f;
#pragma unroll
    for (int s = 0; s < 8; ++s) { const f32x2 v = *(const LAS f32x2*)(lds + HSEG + (s * 128 + 2 * k2) * 4); if (s < seg) { pre0 += v.x; pre1 += v.y; } if (s < 4) { r10 += v.x; r11 += v.y; } tot0 += v.x; tot1 += v.y; }
    const float rb0 = seg >= 4 ? r10 : 0.f, rb1 = seg >= 4 ? r11 : 0.f;
    if (seg == 0) *(LAS f32x2*)(lds + HEBL + 2 * k2 * 4) = (f32x2){__expf(tot0), __expf(tot1)};
    if (64 * n + 8 * seg < si.T) {
        const float er0 = __expf(rb0), er1 = __expf(rb1);
        float ks[8][2];
#pragma unroll
        for (int j = 0; j < 8; ++j) { const int t = 8 * seg + j; const float b0 = pre0 + lf[j][0], b1 = pre1 + lf[j][1];
            const float e0 = __expf(b0 - rb0), e1 = __expf(b1 - rb1);
            *(LAS unsigned*)(lds + HQA + t * 272 + k2 * 4) = pk2(qq[j][0] * e0, qq[j][1] * e1);
            *(LAS unsigned*)(lds + HQS + t * 272 + k2 * 4) = pk2(qq[j][0] * e0 * er0, qq[j][1] * e1 * er1);
            *(LAS unsigned*)(lds + HKD + t * 272 + k2 * 4) = pk2(kk[j][0] * rcpf_(e0), kk[j][1] * rcpf_(e1));
            ks[j][0] = kk[j][0] * __expf(tot0 - b0); ks[j][1] = kk[j][1] * __expf(tot1 - b1); }
        { u32x4 a, b, c, d;
          a.x = pk2(ks[0][0], ks[1][0]); a.y = pk2(ks[2][0], ks[3][0]); a.z = pk2(ks[4][0], ks[5][0]); a.w = pk2(ks[6][0], ks[7][0]);
          b.x = pk2(ks[0][1], ks[1][1]); b.y = pk2(ks[2][1], ks[3][1]); b.z = pk2(ks[4][1], ks[5][1]); b.w = pk2(ks[6][1], ks[7][1]);
          c.x = pk2(vv[0][0], vv[1][0]); c.y = pk2(vv[2][0], vv[3][0]); c.z = pk2(vv[4][0], vv[5][0]); c.w = pk2(vv[6][0], vv[7][0]);
          d.x = pk2(vv[0][1], vv[1][1]); d.y = pk2(vv[2][1], vv[3][1]); d.z = pk2(vv[4][1], vv[5][1]); d.w = pk2(vv[6][1], vv[7][1]);
          *(LAS u32x4*)(lds + HKST + (2 * k2) * 144 + 16 * seg) = a; *(LAS u32x4*)(lds + HKST + (2 * k2 + 1) * 144 + 16 * seg) = b;
          *(LAS u32x4*)(lds + HVT + (2 * k2) * 144 + 16 * seg) = c; *(LAS u32x4*)(lds + HVT + (2 * k2 + 1) * 144 + 16 * seg) = d; }
    } else {
#pragma unroll
        for (int j = 0; j < 8; ++j) { const int t = 8 * seg + j; *(LAS unsigned*)(lds + HQA + t * 272 + k2 * 4) = 0u; *(LAS unsigned*)(lds + HQS + t * 272 + k2 * 4) = 0u; *(LAS unsigned*)(lds + HKD + t * 272 + k2 * 4) = 0u; }
        { const u32x4 z4 = (u32x4){0u, 0u, 0u, 0u};
          *(LAS u32x4*)(lds + HKST + (2 * k2) * 144 + 16 * seg) = z4; *(LAS u32x4*)(lds + HKST + (2 * k2 + 1) * 144 + 16 * seg) = z4;
          *(LAS u32x4*)(lds + HVT + (2 * k2) * 144 + 16 * seg) = z4; *(LAS u32x4*)(lds + HVT + (2 * k2 + 1) * 144 + 16 * seg) = z4; }
    }
    __syncthreads();
#pragma unroll
    for (int tt = 0; tt < 2; ++tt) { const int tile = 2 * w + tt, ti = tile >> 2, sj = tile & 3;
        if (ti < nti) {
            f32x4 acc = (f32x4){0.f, 0.f, 0.f, 0.f};
            if (sj <= ti) { const int qb = (ti >= 2 && sj < 2) ? HQS : HQA; bf16x8 kf[4], qf[4];
#pragma unroll
                for (int ks = 0; ks < 4; ++ks) { kf[ks] = ldfrag(lds, HKD + (16 * sj + fr) * 272 + (32 * ks + 8 * fq) * 2); qf[ks] = ldfrag(lds, qb + (16 * ti + fr) * 272 + (32 * ks + 8 * fq) * 2); }
                __builtin_amdgcn_sched_barrier(0);
#pragma unroll
                for (int ks = 0; ks < 4; ++ks) acc = MFMA16(kf[ks], qf[ks], acc);
                const int t = 16 * ti + fr;
#pragma unroll
                for (int r = 0; r < 4; ++r) if (16 * sj + 4 * fq + r > t) acc[r] = 0.f; }
            *(LAS u32x2*)(lds + HPB + (16 * ti + fr) * 144 + (16 * sj + 4 * fq) * 2) = pack4(acc[0], acc[1], acc[2], acc[3]); } }
    __syncthreads();
}
__device__ __forceinline__ void hgrn_a_item(const Params& P, const Ctx& C, int l, int item) {
    int tid = C.tid; asm volatile("" : "+v"(tid)); const int lane = tid & 63, w = C.wave, fr = lane & 15, fq = lane >> 4;
    const int n = item & 31, h = (item >> 5) & 7, sq = item >> 8;
    const SeqInfo si = seq_info(sq); LAS unsigned char* lds = C.lds; bf16_t* OHG = WSP(bf16_t, WS_OHG);
    unsigned char* rec = C.ws + WS_HREC + (size_t)item * HREC;
    hgrn_stage_att(P, C, l, si, h, n, 4, tid, w, fr, fq);
    { bf16x8 vf[2], pf[4][2];
#pragma unroll
      for (int ks = 0; ks < 2; ++ks) { vf[ks] = ldfrag(lds, HVT + (16 * w + fr) * 144 + (32 * ks + 8 * fq) * 2);
#pragma unroll
          for (int ti = 0; ti < 4; ++ti) pf[ti][ks] = ldfrag(lds, HPB + (16 * ti + fr) * 144 + (32 * ks + 8 * fq) * 2); }
      __builtin_amdgcn_sched_barrier(0);
#pragma unroll
      for (int ti = 0; ti < 4; ++ti) { f32x4 acc = (f32x4){0.f, 0.f, 0.f, 0.f};
#pragma unroll
          for (int ks = 0; ks < 2; ++ks) acc = MFMA16(vf[ks], pf[ti][ks], acc);
          *(u32x2*)(OHG + (size_t)(si.base + 64 * n + 16 * ti + fr) * 1024 + h * 128 + 16 * w + 4 * fq) = pack4(acc[0], acc[1], acc[2], acc[3]); }
      bf16x8 af[8][2];
#pragma unroll
      for (int kt = 0; kt < 8; ++kt)
#pragma unroll
          for (int ks = 0; ks < 2; ++ks) af[kt][ks] = ldfrag(lds, HKST + (16 * kt + fr) * 144 + (32 * ks + 8 * fq) * 2);
      __builtin_amdgcn_sched_barrier(0);
#pragma unroll
      for (int kt = 0; kt < 8; ++kt) { f32x4 acc = (f32x4){0.f, 0.f, 0.f, 0.f};
#pragma unroll
          for (int ks = 0; ks < 2; ++ks) acc = MFMA16(af[kt][ks], vf[ks], acc);
          *(u32x2*)(rec + 17920 + ((size_t)(kt * 128 + 16 * w + fr) * 16 + 4 * fq) * 2) = pack4(acc[0], acc[1], acc[2], acc[3]); } }
    for (int i = tid; i < 1120; i += NTHREADS) ((u32x4*)rec)[i] = *(const LAS u32x4*)(lds + (i < 1088 ? HQS + i * 16 : HEBL + (i - 1088) * 16));
    __syncthreads();
}
__device__ __forceinline__ void hgrn_b_task(const Params& P, const Ctx& C, int l, int sq, int h) {
    int tid = C.tid; asm volatile("" : "+v"(tid)); const int lane = tid & 63, w = C.wave, fr = lane & 15, fq = lane >> 4;
    const SeqInfo si = seq_info(sq); LAS unsigned char* lds = C.lds; bf16_t* OHG = WSP(bf16_t, WS_OHG);
    float* Sout = C.out + OFF_HGP + (((size_t)l * 4 + si.b) * 8 + h) * 16384;
    const unsigned char* rec0 = C.ws + WS_HREC + (size_t)((sq * 8 + h) * 32) * HREC;
    f32x4 sacc[8];
#pragma unroll
    for (int kt = 0; kt < 8; ++kt) { sacc[kt] = (f32x4){0.f, 0.f, 0.f, 0.f}; *(LAS u32x2*)(lds + HST + (16 * w + fr) * 272 + (16 * kt + 4 * fq) * 2) = (u32x2){0u, 0u}; }
    u32x4 pq[3];
    auto gq = [&](int n) { const u32x4* src = (const u32x4*)(rec0 + (size_t)n * HREC);
#pragma unroll
        for (int q = 0; q < 3; ++q) { const int i = tid + 512 * q; pq[q] = src[i < 1088 ? i : 1087]; } };
    auto lq = [&](int n) { LAS u32x4* dst = (LAS u32x4*)(lds + ((n & 1) ? HQS : HQA));
#pragma unroll
        for (int q = 0; q < 3; ++q) { const int i = tid + 512 * q; if (i < 1088) dst[i] = pq[q]; } };
    gq(0); lq(0);
    __syncthreads();
    for (int n = 0; n < 32; ++n) {
        const unsigned char* rec = rec0 + (size_t)n * HREC;
        if (n + 1 < 32) gq(n + 1);
        u32x2 Lr[8]; f32x4 eb[8];
#pragma unroll
        for (int kt = 0; kt < 8; ++kt) { Lr[kt] = *(const u32x2*)(rec + 17920 + ((size_t)(kt * 128 + 16 * w + fr) * 16 + 4 * fq) * 2); eb[kt] = *(const f32x4*)(rec + 17408 + (16 * kt + 4 * fq) * 4); }
        const int qb = (n & 1) ? HQS : HQA;
        bf16_t* op0 = OHG + (size_t)(si.base + 64 * n + fr) * 1024 + h * 128 + 16 * w + 4 * fq;
        u32x2 oraw[4]; f32x4 oacc[4];
#pragma unroll
        for (int ti = 0; ti < 4; ++ti) oraw[ti] = *(const u32x2*)(op0 + (size_t)ti * 16 * 1024);
        { bf16x8 sf[4];
#pragma unroll
          for (int ks = 0; ks < 4; ++ks) sf[ks] = ldfrag(lds, HST + (16 * w + fr) * 272 + (32 * ks + 8 * fq) * 2);
#pragma unroll
          for (int tp = 0; tp < 2; ++tp) { bf16x8 qf[2][4];
#pragma unroll
              for (int t2 = 0; t2 < 2; ++t2)
#pragma unroll
                  for (int ks = 0; ks < 4; ++ks) qf[t2][ks] = ldfrag(lds, qb + (16 * (2 * tp + t2) + fr) * 272 + (32 * ks + 8 * fq) * 2);
              __builtin_amdgcn_sched_barrier(0);
#pragma unroll
              for (int t2 = 0; t2 < 2; ++t2) { f32x4 acc = (f32x4){0.f, 0.f, 0.f, 0.f};
#pragma unroll
                  for (int ks = 0; ks < 4; ++ks) acc = MFMA16(sf[ks], qf[t2][ks], acc);
                  oacc[2 * tp + t2] = acc; } } }
        asm volatile("" ::: "memory");
#pragma unroll
        for (int kt = 0; kt < 8; ++kt) { float l4[4]; unpack4(Lr[kt], l4); sacc[kt] = sacc[kt] * eb[kt] + (f32x4){l4[0], l4[1], l4[2], l4[3]};
            *(LAS u32x2*)(lds + HST + (16 * w + fr) * 272 + (16 * kt + 4 * fq) * 2) = pack4(sacc[kt][0], sacc[kt][1], sacc[kt][2], sacc[kt][3]); }
#pragma unroll
        for (int ti = 0; ti < 4; ++ti) { float o4[4]; unpack4(oraw[ti], o4); *(u32x2*)(op0 + (size_t)ti * 16 * 1024) = pack4(oacc[ti][0] + o4[0], oacc[ti][1] + o4[1], oacc[ti][2] + o4[2], oacc[ti][3] + o4[3]); }
        if (n + 1 < 32) lq(n + 1);
        __syncthreads();
    }
#pragma unroll
    for (int kt = 0; kt < 8; ++kt)
#pragma unroll
        for (int r = 0; r < 4; ++r) Sout[(size_t)(16 * kt + 4 * fq + r) * 128 + 16 * w + fr] = sacc[kt][r];
}
__device__ __forceinline__ void hgrn_task(const Params& P, const Ctx& C, int l, int sq, int hq) {
    int tid = C.tid; asm volatile("" : "+v"(tid)); const SeqInfo si = seq_info(sq); const int lane = tid & 63, w = C.wave, fr = lane & 15, fq = lane >> 4;
    LAS unsigned char* lds = C.lds; bf16_t* OHG = WSP(bf16_t, WS_OHG);
    f32x4 nxt[8];
    { const float* S0 = P.in[2] + (((size_t)l * 128 + si.b) * 8 + 4 * hq) * 16384;
#pragma unroll
      for (int kt = 0; kt < 8; ++kt)
#pragma unroll
        for (int r = 0; r < 4; ++r) nxt[kt][r] = S0[(size_t)(16 * kt + 4 * fq + r) * 128 + 16 * w + fr]; }
#pragma unroll 1
    for (int hh0 = 0; hh0 < 4; ++hh0) {
        int hh = hh0; asm volatile("" : "+s"(hh));
        const int h = 4 * hq + hh;
        float* Sout = C.out + OFF_HGS + (((size_t)l * 128 + si.b) * 8 + h) * 16384;
        f32x4 sacc[8];
#pragma unroll
        for (int kt = 0; kt < 8; ++kt) { sacc[kt] = nxt[kt];
            *(LAS u32x2*)(lds + HST + (16 * w + fr) * 272 + (16 * kt + 4 * fq) * 2) = pack4(sacc[kt][0], sacc[kt][1], sacc[kt][2], sacc[kt][3]); }
        hgrn_stage_att(P, C, l, si, h, 0, 1, tid, w, fr, fq);
        if (hh < 3) { const float* S1 = P.in[2] + (((size_t)l * 128 + si.b) * 8 + h + 1) * 16384;
#pragma unroll
            for (int kt = 0; kt < 8; ++kt)
#pragma unroll
                for (int r = 0; r < 4; ++r) nxt[kt][r] = S1[(size_t)(16 * kt + 4 * fq + r) * 128 + 16 * w + fr]; }
        { f32x4 acc = (f32x4){0.f, 0.f, 0.f, 0.f};
          { const bf16x8 vf = ldfrag(lds, HVT + (16 * w + fr) * 144 + (8 * fq) * 2), pf = ldfrag(lds, HPB + fr * 144 + (8 * fq) * 2); acc = MFMA16(vf, pf, acc); }
#pragma unroll
          for (int ks = 0; ks < 4; ++ks) { const bf16x8 sf = ldfrag(lds, HST + (16 * w + fr) * 272 + (32 * ks + 8 * fq) * 2), qf = ldfrag(lds, HQS + fr * 272 + (32 * ks + 8 * fq) * 2); acc = MFMA16(sf, qf, acc); }
          if (fr < si.T) *(u32x2*)(OHG + (size_t)(si.base + fr) * 1024 + h * 128 + 16 * w + 4 * fq) = pack4(acc[0], acc[1], acc[2], acc[3]); }
#pragma unroll
        for (int kt = 0; kt < 8; ++kt) { const f32x4 e = *(const LAS f32x4*)(lds + HEBL + (16 * kt + 4 * fq) * 4); sacc[kt] *= e;
            { const bf16x8 af = ldfrag(lds, HKST + (16 * kt + fr) * 144 + (8 * fq) * 2), bf = ldfrag(lds, HVT + (16 * w + fr) * 144 + (8 * fq) * 2); sacc[kt] = MFMA16(af, bf, sacc[kt]); }
#pragma unroll
            for (int r = 0; r < 4; ++r) Sout[(size_t)(16 * kt + 4 * fq + r) * 128 + 16 * w + fr] = sacc[kt][r]; }
        __syncthreads();
    }
}

constexpr size_t RQAREC = 33792, RLREC = 131072;
__device__ __forceinline__ void ret_a_item(const Params& P, const Ctx& C, int l, int item) {
    int tid = C.tid; asm volatile("" : "+v"(tid)); const int lane = tid & 63, w = C.wave, fr = lane & 15, fq = lane >> 4;
    const int n = item & 31, h = (item >> 5) & 3, sq = item >> 7;
    const SeqInfo si = seq_info(sq); LAS unsigned char* lds = C.lds;
    constexpr int QA = 0, KA = 33792, KAT = 67584, VT = 104448, PB = 122880;
    const bf16_t* Z = WSP(bf16_t, WS_Z); bf16_t* ORN = WSP(bf16_t, WS_ORN); const f32x2* rope = WSP(f32x2, WS_ROPE);
    unsigned char* rqa = C.ws + WS_RQA + (size_t)item * RQAREC; bf16_t* rl = (bf16_t*)((unsigned char*)C.out + (size_t)item * RLREC);
    const float lg = __logf(1.f - exp2f(-5.f - (float)h));
    const int i2 = tid & 63, tq = tid >> 6;
#pragma unroll
    for (int j = 0; j < 8; j += 2) {
        float kt1[2][2], kt2[2][2];
#pragma unroll
        for (int jj = 0; jj < 2; ++jj) { const int t = 8 * tq + j + jj, tl = 64 * n + t;
            const bf16_t* zr = Z + (size_t)(si.base + tl) * NPAD + h * 256 + 2 * i2;
            const unsigned xq1 = *(const unsigned*)(zr + ZRQ), xq2 = *(const unsigned*)(zr + ZRQ + 128), xk1 = *(const unsigned*)(zr + ZRK), xk2 = *(const unsigned*)(zr + ZRK + 128);
            const f32x4 cs = *(const f32x4*)(rope + (size_t)tl * 128 + 2 * i2);
            const float q1a = bflo(xq1) * cs[0] - bflo(xq2) * cs[1], q2a = bflo(xq1) * cs[1] + bflo(xq2) * cs[0];
            const float q1b = bfhi(xq1) * cs[2] - bfhi(xq2) * cs[3], q2b = bfhi(xq1) * cs[3] + bfhi(xq2) * cs[2];
            const float k1a = (bflo(xk1) * cs[0] - bflo(xk2) * cs[1]) * 0.0625f, k2a = (bflo(xk1) * cs[1] + bflo(xk2) * cs[0]) * 0.0625f;
            const float k1b = (bfhi(xk1) * cs[2] - bfhi(xk2) * cs[3]) * 0.0625f, k2b = (bfhi(xk1) * cs[3] + bfhi(xk2) * cs[2]) * 0.0625f;
            *(LAS unsigned*)(lds + QA + t * 528 + i2 * 4) = pk2(q1a, q1b); *(LAS unsigned*)(lds + QA + t * 528 + 256 + i2 * 4) = pk2(q2a, q2b);
            *(LAS unsigned*)(lds + KA + t * 528 + i2 * 4) = pk2(k1a, k1b); *(LAS unsigned*)(lds + KA + t * 528 + 256 + i2 * 4) = pk2(k2a, k2b);
            const float kd = __expf(lg * (float)(63 - t));
            kt1[jj][0] = k1a * kd; kt1[jj][1] = k1b * kd; kt2[jj][0] = k2a * kd; kt2[jj][1] = k2b * kd; }
        const int t = 8 * tq + j;
        *(LAS unsigned*)(lds + KAT + (2 * i2) * 144 + t * 2) = pk2(kt1[0][0], kt1[1][0]);
        *(LAS unsigned*)(lds + KAT + (2 * i2 + 1) * 144 + t * 2) = pk2(kt1[0][1], kt1[1][1]);
        *(LAS unsigned*)(lds + KAT + (128 + 2 * i2) * 144 + t * 2) = pk2(kt2[0][0], kt2[1][0]);
        *(LAS unsigned*)(lds + KAT + (128 + 2 * i2 + 1) * 144 + t * 2) = pk2(kt2[0][1], kt2[1][1]);
    }
    __syncthreads();
#pragma unroll
    for (int tt = 0; tt < 2; ++tt) { const int tile = 2 * w + tt, ti = tile >> 2, sj = tile & 3;
        f32x4 acc = (f32x4){0.f, 0.f, 0.f, 0.f};
        if (sj <= ti) { bf16x8 kf[8], qf[8];
#pragma unroll
            for (int ks = 0; ks < 8; ++ks) { kf[ks] = ldfrag(lds, KA + (16 * sj + fr) * 528 + (32 * ks + 8 * fq) * 2); qf[ks] = ldfrag(lds, QA + (16 * ti + fr) * 528 + (32 * ks + 8 * fq) * 2); }
            __builtin_amdgcn_sched_barrier(0);
#pragma unroll
            for (int ks = 0; ks < 8; ++ks) acc = MFMA16(kf[ks], qf[ks], acc);
            const int t = 16 * ti + fr;
#pragma unroll
            for (int r = 0; r < 4; ++r) { const int ss = 16 * sj + 4 * fq + r; acc[r] = (ss > t) ? 0.f : acc[r] * __expf(lg * (float)(t - ss)); } }
        *(LAS u32x2*)(lds + PB + (16 * ti + fr) * 144 + (16 * sj + 4 * fq) * 2) = pack4(acc[0], acc[1], acc[2], acc[3]); }
    unsigned vpk[2][8];
    { const int v = tid & 127, tq4 = tid >> 7;
#pragma unroll
      for (int vh = 0; vh < 2; ++vh)
#pragma unroll
        for (int j = 0; j < 16; j += 2) { const int t = 16 * tq4 + j;
            const unsigned x0 = Z[(size_t)(si.base + 64 * n + t) * NPAD + ZRV + h * 256 + vh * 128 + v], x1 = Z[(size_t)(si.base + 64 * n + t + 1) * NPAD + ZRV + h * 256 + vh * 128 + v];
            vpk[vh][j >> 1] = x0 | (x1 << 16); } }
#pragma unroll
    for (int vh = 0; vh < 2; ++vh) {
        __syncthreads();
        { const int v = tid & 127, tq4 = tid >> 7;
#pragma unroll
            for (int j = 0; j < 16; j += 2) { const int t = 16 * tq4 + j; *(LAS unsigned*)(lds + VT + v * 144 + t * 2) = vpk[vh][j >> 1]; } }
        __syncthreads();
        { bf16x8 vf[2], pf[4][2];
#pragma unroll
          for (int ks = 0; ks < 2; ++ks) { vf[ks] = ldfrag(lds, VT + (16 * w + fr) * 144 + (32 * ks + 8 * fq) * 2);
#pragma unroll
              for (int ti = 0; ti < 4; ++ti) pf[ti][ks] = ldfrag(lds, PB + (16 * ti + fr) * 144 + (32 * ks + 8 * fq) * 2); }
          __builtin_amdgcn_sched_barrier(0);
#pragma unroll
          for (int ti = 0; ti < 4; ++ti) { f32x4 acc = (f32x4){0.f, 0.f, 0.f, 0.f};
#pragma unroll
              for (int ks = 0; ks < 2; ++ks) acc = MFMA16(vf[ks], pf[ti][ks], acc);
              *(u32x2*)(ORN + (size_t)(si.base + 64 * n + 16 * ti + fr) * 1024 + h * 256 + vh * 128 + 16 * w + 4 * fq) = pack4(acc[0], acc[1], acc[2], acc[3]); }
#pragma unroll
          for (int kg = 0; kg < 2; ++kg) { bf16x8 af[8][2];
#pragma unroll
              for (int kk = 0; kk < 8; ++kk)
#pragma unroll
                  for (int ks = 0; ks < 2; ++ks) af[kk][ks] = ldfrag(lds, KAT + (16 * (8 * kg + kk) + fr) * 144 + (32 * ks + 8 * fq) * 2);
              __builtin_amdgcn_sched_barrier(0);
#pragma unroll
              for (int kk = 0; kk < 8; ++kk) { const int kt = 8 * kg + kk; f32x4 acc = (f32x4){0.f, 0.f, 0.f, 0.f};
#pragma unroll
                  for (int ks = 0; ks < 2; ++ks) acc = MFMA16(af[kk][ks], vf[ks], acc);
                  *(u32x2*)(rl + ((size_t)kt * 256 + vh * 128 + 16 * w + fr) * 16 + 4 * fq) = pack4(acc[0], acc[1], acc[2], acc[3]); } } }
    }
    for (int i = tid; i < 2112; i += NTHREADS) ((u32x4*)rqa)[i] = *(const LAS u32x4*)(lds + QA + i * 16);
    __syncthreads();
}
__device__ __forceinline__ void ret_b_task(const Params& P, const Ctx& C, int l, int sq, int h, int vh) {
    int tid = C.tid; asm volatile("" : "+v"(tid)); const int lane = tid & 63, w = C.wave, fr = lane & 15, fq = lane >> 4;
    const SeqInfo si = seq_info(sq); LAS unsigned char* lds = C.lds; bf16_t* ORN = WSP(bf16_t, WS_ORN);
    constexpr int ST = 0, QB0 = 67584;
    float* Sout = C.out + OFF_RNP + (((size_t)l * 4 + si.b) * 4 + h) * 65536;
    const int item0 = (sq * 4 + h) * 32;
    const float lg = __logf(1.f - exp2f(-5.f - (float)h)); const float cdec = __expf(lg * 64.f);
    f32x4 sacc[16];
#pragma unroll
    for (int kt = 0; kt < 16; ++kt) { sacc[kt] = (f32x4){0.f, 0.f, 0.f, 0.f}; *(LAS u32x2*)(lds + ST + (16 * w + fr) * 528 + (16 * kt + 4 * fq) * 2) = (u32x2){0u, 0u}; }
    u32x4 pq[5];
    auto gq = [&](int n) { const u32x4* src = (const u32x4*)(C.ws + WS_RQA + (size_t)(item0 + n) * RQAREC);
#pragma unroll
        for (int q = 0; q < 5; ++q) { const int i = tid + 512 * q; pq[q] = src[i < 2112 ? i : 2111]; } };
    auto lq = [&](int n) { LAS u32x4* dst = (LAS u32x4*)(lds + QB0 + (n & 1) * 33792);
#pragma unroll
        for (int q = 0; q < 5; ++q) { const int i = tid + 512 * q; if (i < 2112) dst[i] = pq[q]; } };
    gq(0); lq(0);
    __syncthreads();
    for (int n = 0; n < 32; ++n) {
        if (n + 1 < 32) gq(n + 1);
        const bf16_t* rl = (const bf16_t*)((const unsigned char*)C.out + (size_t)(item0 + n) * RLREC) + (size_t)(vh * 128 + 16 * w + fr) * 16 + 4 * fq;
        u32x2 Lr[16];
#pragma unroll
        for (int kt = 0; kt < 16; ++kt) Lr[kt] = *(const u32x2*)(rl + (size_t)kt * 4096);
        const int qb = QB0 + (n & 1) * 33792;
        bf16_t* op0 = ORN + (size_t)(si.base + 64 * n + fr) * 1024 + h * 256 + vh * 128 + 16 * w + 4 * fq;
        u32x2 oraw[4]; f32x4 oacc[4];
#pragma unroll
        for (int ti = 0; ti < 4; ++ti) oraw[ti] = *(const u32x2*)(op0 + (size_t)ti * 16 * 1024);
#pragma unroll
        for (int ti = 0; ti < 4; ++ti) { f32x4 acc = (f32x4){0.f, 0.f, 0.f, 0.f};
#pragma unroll
            for (int ks = 0; ks < 8; ++ks) { const bf16x8 sf = ldfrag(lds, ST + (16 * w + fr) * 528 + (32 * ks + 8 * fq) * 2), qf = ldfrag(lds, qb + (16 * ti + fr) * 528 + (32 * ks + 8 * fq) * 2); acc = MFMA16(sf, qf, acc); }
            oacc[ti] = acc; }
        asm volatile("" ::: "memory");
#pragma unroll
        for (int kt = 0; kt < 16; ++kt) { float l4[4]; unpack4(Lr[kt], l4);
            sacc[kt][0] = sacc[kt][0] * cdec + l4[0]; sacc[kt][1] = sacc[kt][1] * cdec + l4[1]; sacc[kt][2] = sacc[kt][2] * cdec + l4[2]; sacc[kt][3] = sacc[kt][3] * cdec + l4[3];
            *(LAS u32x2*)(lds + ST + (16 * w + fr) * 528 + (16 * kt + 4 * fq) * 2) = pack4(sacc[kt][0], sacc[kt][1], sacc[kt][2], sacc[kt][3]); }
#pragma unroll
        for (int ti = 0; ti < 4; ++ti) { float o4[4]; unpack4(oraw[ti], o4); const float qd = __expf(lg * (float)(16 * ti + fr + 1));
            *(u32x2*)(op0 + (size_t)ti * 16 * 1024) = pack4(o4[0] + qd * oacc[ti][0], o4[1] + qd * oacc[ti][1], o4[2] + qd * oacc[ti][2], o4[3] + qd * oacc[ti][3]); }
        if (n + 1 < 32) lq(n + 1);
        __syncthreads();
    }
#pragma unroll
    for (int kt = 0; kt < 16; ++kt)
#pragma unroll
        for (int r = 0; r < 4; ++r) Sout[(size_t)(16 * kt + 4 * fq + r) * 256 + vh * 128 + 16 * w + fr] = sacc[kt][r];
}
__device__ __forceinline__ void ret_task(const Params& P, const Ctx& C, int l, int sq, int h, int vs) {
    int tid = C.tid; asm volatile("" : "+v"(tid)); const SeqInfo si = seq_info(sq); const int lane = tid & 63, w = C.wave, fr = lane & 15, fq = lane >> 4;
    LAS unsigned char* lds = C.lds;
    constexpr int QA = 0, KA = 33792, KAT = 67584, VT = 104448, VDT = 109056, PB = 113664, ST = 122880;
    const bf16_t* Z = WSP(bf16_t, WS_Z); bf16_t* ORN = WSP(bf16_t, WS_ORN); const f32x2* rope = WSP(f32x2, WS_ROPE);
    const float* S0 = si.prompt ? nullptr : P.in[5] + (((size_t)l * 128 + si.b) * 4 + h) * 65536;
    float* Sout = si.prompt ? C.out + OFF_RNP + (((size_t)l * 4 + si.b) * 4 + h) * 65536 : C.out + OFF_RNS + (((size_t)l * 128 + si.b) * 4 + h) * 65536;
    const float lg = __logf(1.f - exp2f(-5.f - (float)h));
    const int Cc = si.T < 64 ? si.T : 64; const float cdec = __expf(lg * (float)Cc);
    const int vi = w & 1, ktb = 4 * (w >> 1);
    f32x4 sacc[4];
#pragma unroll
    for (int m = 0; m < 4; ++m) { const int kt = ktb + m;
        if (S0) {
#pragma unroll
            for (int r = 0; r < 4; ++r) sacc[m][r] = S0[(size_t)(16 * kt + 4 * fq + r) * 256 + vs * 32 + 16 * vi + fr]; }
        else sacc[m] = (f32x4){0.f, 0.f, 0.f, 0.f};
        *(LAS u32x2*)(lds + ST + (16 * vi + fr) * 528 + (16 * kt + 4 * fq) * 2) = pack4(sacc[m][0], sacc[m][1], sacc[m][2], sacc[m][3]); }
    const int i2 = tid & 63, tq = tid >> 6;
    const int nch = (si.T + 63) >> 6;
    for (int n = 0; n < nch; ++n) {
#pragma unroll
        for (int j = 0; j < 8; j += 2) {
            float kt1[2][2], kt2[2][2];
#pragma unroll
            for (int jj = 0; jj < 2; ++jj) { const int t = 8 * tq + j + jj, tl = 64 * n + t;
                float q1a = 0.f, q1b = 0.f, q2a = 0.f, q2b = 0.f, k1a = 0.f, k1b = 0.f, k2a = 0.f, k2b = 0.f;
                if (tl < si.T) { const bf16_t* zr = Z + (size_t)(si.base + tl) * NPAD + h * 256 + 2 * i2;
                    const unsigned xq1 = *(const unsigned*)(zr + ZRQ), xq2 = *(const unsigned*)(zr + ZRQ + 128), xk1 = *(const unsigned*)(zr + ZRK), xk2 = *(const unsigned*)(zr + ZRK + 128);
                    const int pidx = si.prompt ? tl : 2048 + tl;
                    const f32x4 cs = *(const f32x4*)(rope + (size_t)pidx * 128 + 2 * i2);
                    q1a = bflo(xq1) * cs[0] - bflo(xq2) * cs[1]; q2a = bflo(xq1) * cs[1] + bflo(xq2) * cs[0];
                    q1b = bfhi(xq1) * cs[2] - bfhi(xq2) * cs[3]; q2b = bfhi(xq1) * cs[3] + bfhi(xq2) * cs[2];
                    k1a = (bflo(xk1) * cs[0] - bflo(xk2) * cs[1]) * 0.0625f; k2a = (bflo(xk1) * cs[1] + bflo(xk2) * cs[0]) * 0.0625f;
                    k1b = (bfhi(xk1) * cs[2] - bfhi(xk2) * cs[3]) * 0.0625f; k2b = (bfhi(xk1) * cs[3] + bfhi(xk2) * cs[2]) * 0.0625f; }
                *(LAS unsigned*)(lds + QA + t * 528 + i2 * 4) = pk2(q1a, q1b); *(LAS unsigned*)(lds + QA + t * 528 + 256 + i2 * 4) = pk2(q2a, q2b);
                *(LAS unsigned*)(lds + KA + t * 528 + i2 * 4) = pk2(k1a, k1b); *(LAS unsigned*)(lds + KA + t * 528 + 256 + i2 * 4) = pk2(k2a, k2b);
                kt1[jj][0] = k1a; kt1[jj][1] = k1b; kt2[jj][0] = k2a; kt2[jj][1] = k2b; }
            const int t = 8 * tq + j;
            *(LAS unsigned*)(lds + KAT + (2 * i2) * 144 + t * 2) = pk2(kt1[0][0], kt1[1][0]);
            *(LAS unsigned*)(lds + KAT + (2 * i2 + 1) * 144 + t * 2) = pk2(kt1[0][1], kt1[1][1]);
            *(LAS unsigned*)(lds + KAT + (128 + 2 * i2) * 144 + t * 2) = pk2(kt2[0][0], kt2[1][0]);
            *(LAS unsigned*)(lds + KAT + (128 + 2 * i2 + 1) * 144 + t * 2) = pk2(kt2[0][1], kt2[1][1]);
        }
        { const int v = tid & 31, tq4 = tid >> 5;
#pragma unroll
            for (int j = 0; j < 4; j += 2) { float x[2], xd[2];
#pragma unroll
                for (int jj = 0; jj < 2; ++jj) { const int t = 4 * tq4 + j + jj, tl = 64 * n + t; x[jj] = 0.f; xd[jj] = 0.f;
                    if (tl < si.T) { x[jj] = bf2f(Z[(size_t)(si.base + tl) * NPAD + ZRV + h * 256 + vs * 32 + v]); xd[jj] = x[jj] * __expf(lg * (float)(Cc - 1 - t)); } }
                const int t = 4 * tq4 + j;
                *(LAS unsigned*)(lds + VT + v * 144 + t * 2) = pk2(x[0], x[1]); *(LAS unsigned*)(lds + VDT + v * 144 + t * 2) = pk2(xd[0], xd[1]); } }
        __syncthreads();
#pragma unroll
        for (int tt = 0; tt < 2; ++tt) { const int tile = 2 * w + tt, ti = tile >> 2, sj = tile & 3;
            if (16 * ti >= Cc) continue;
            f32x4 acc = (f32x4){0.f, 0.f, 0.f, 0.f};
            if (sj <= ti) {
#pragma unroll
                for (int ks = 0; ks < 8; ++ks) { const bf16x8 kf = ldfrag(lds, KA + (16 * sj + fr) * 528 + (32 * ks + 8 * fq) * 2), qf = ldfrag(lds, QA + (16 * ti + fr) * 528 + (32 * ks + 8 * fq) * 2); acc = MFMA16(kf, qf, acc); }
                const int t = 16 * ti + fr;
#pragma unroll
                for (int r = 0; r < 4; ++r) { const int s = 16 * sj + 4 * fq + r; acc[r] = (s > t) ? 0.f : acc[r] * __expf(lg * (float)(t - s)); } }
            *(LAS u32x2*)(lds + PB + (16 * ti + fr) * 144 + (16 * sj + 4 * fq) * 2) = pack4(acc[0], acc[1], acc[2], acc[3]); }
        __syncthreads();
        if (16 * (w >> 1) < Cc) { const int ti = w >> 1; f32x4 a1 = (f32x4){0.f, 0.f, 0.f, 0.f}, a2 = a1;
#pragma unroll
            for (int ks = 0; ks < 2; ++ks) { const bf16x8 vf = ldfrag(lds, VT + (16 * vi + fr) * 144 + (32 * ks + 8 * fq) * 2), pf = ldfrag(lds, PB + (16 * ti + fr) * 144 + (32 * ks + 8 * fq) * 2); a1 = MFMA16(vf, pf, a1); }
#pragma unroll
            for (int ks = 0; ks < 8; ++ks) { const bf16x8 sf = ldfrag(lds, ST + (16 * vi + fr) * 528 + (32 * ks + 8 * fq) * 2), qf = ldfrag(lds, QA + (16 * ti + fr) * 528 + (32 * ks + 8 * fq) * 2); a2 = MFMA16(sf, qf, a2); }
            const int t = 16 * ti + fr, tl = 64 * n + t; const float qd = __expf(lg * (float)(t + 1));
            if (tl < si.T) *(u32x2*)(ORN + (size_t)(si.base + tl) * 1024 + h * 256 + vs * 32 + 16 * vi + 4 * fq) = pack4(a1[0] + qd * a2[0], a1[1] + qd * a2[1], a1[2] + qd * a2[2], a1[3] + qd * a2[3]); }
        __syncthreads();
#pragma unroll
        for (int m = 0; m < 4; ++m) { const int kt = ktb + m; sacc[m] *= cdec;
#pragma unroll
            for (int ks = 0; ks < 2; ++ks) { const bf16x8 af = ldfrag(lds, KAT + (16 * kt + fr) * 144 + (32 * ks + 8 * fq) * 2), bf = ldfrag(lds, VDT + (16 * vi + fr) * 144 + (32 * ks + 8 * fq) * 2); sacc[m] = MFMA16(af, bf, sacc[m]); }
            *(LAS u32x2*)(lds + ST + (16 * vi + fr) * 528 + (16 * kt + 4 * fq) * 2) = pack4(sacc[m][0], sacc[m][1], sacc[m][2], sacc[m][3]); }
        __syncthreads();
    }
#pragma unroll
    for (int m = 0; m < 4; ++m)
#pragma unroll
        for (int r = 0; r < 4; ++r) Sout[(size_t)(16 * (ktb + m) + 4 * fq + r) * 256 + vs * 32 + 16 * vi + fr] = sacc[m][r];
}

__device__ __forceinline__ void ret_s_task(const Params& P, const Ctx& C, int l, int sq, int h) {
    int tid = C.tid; asm volatile("" : "+v"(tid)); const SeqInfo si = seq_info(sq); const int lane = tid & 63, w = C.wave, fr = lane & 15, fq = lane >> 4;
    LAS unsigned char* lds = C.lds;
    constexpr int QA = 0, KA = 8448, KAT = 16896, VT = 53760, VDT = 58368, PB = 62976, ST = 65280;
    const bf16_t* Z = WSP(bf16_t, WS_Z); bf16_t* ORN = WSP(bf16_t, WS_ORN); const f32x2* rope = WSP(f32x2, WS_ROPE);
    const float* S0 = P.in[5] + (((size_t)l * 128 + si.b) * 4 + h) * 65536;
    float* Sout = C.out + OFF_RNS + (((size_t)l * 128 + si.b) * 4 + h) * 65536;
    const float lg = __logf(1.f - exp2f(-5.f - (float)h)); const float cdec = __expf(lg * 8.f);
    const int vi = w & 1, ktb = 4 * (w >> 1);
    f32x4 nxt[4];
#pragma unroll
    for (int m = 0; m < 4; ++m)
#pragma unroll
        for (int r = 0; r < 4; ++r) nxt[m][r] = S0[(size_t)(16 * (ktb + m) + 4 * fq + r) * 256 + 16 * vi + fr];
    { const int i2 = tid & 63, tq = tid >> 6;
      float k1[2][2], k2[2][2];
#pragma unroll
      for (int jj = 0; jj < 2; ++jj) { const int t = 2 * tq + jj;
          float q1a = 0.f, q1b = 0.f, q2a = 0.f, q2b = 0.f; k1[jj][0] = k1[jj][1] = k2[jj][0] = k2[jj][1] = 0.f;
          if (tq < 4) { const bf16_t* zr = Z + (size_t)(si.base + t) * NPAD + h * 256 + 2 * i2;
              const unsigned xq1 = *(const unsigned*)(zr + ZRQ), xq2 = *(const unsigned*)(zr + ZRQ + 128), xk1 = *(const unsigned*)(zr + ZRK), xk2 = *(const unsigned*)(zr + ZRK + 128);
              const f32x4 cs = *(const f32x4*)(rope + (size_t)(2048 + t) * 128 + 2 * i2);
              q1a = bflo(xq1) * cs[0] - bflo(xq2) * cs[1]; q2a = bflo(xq1) * cs[1] + bflo(xq2) * cs[0];
              q1b = bfhi(xq1) * cs[2] - bfhi(xq2) * cs[3]; q2b = bfhi(xq1) * cs[3] + bfhi(xq2) * cs[2];
              k1[jj][0] = (bflo(xk1) * cs[0] - bflo(xk2) * cs[1]) * 0.0625f; k2[jj][0] = (bflo(xk1) * cs[1] + bflo(xk2) * cs[0]) * 0.0625f;
              k1[jj][1] = (bfhi(xk1) * cs[2] - bfhi(xk2) * cs[3]) * 0.0625f; k2[jj][1] = (bfhi(xk1) * cs[3] + bfhi(xk2) * cs[2]) * 0.0625f; }
          *(LAS unsigned*)(lds + QA + t * 528 + i2 * 4) = pk2(q1a, q1b); *(LAS unsigned*)(lds + QA + t * 528 + 256 + i2 * 4) = pk2(q2a, q2b);
          *(LAS unsigned*)(lds + KA + t * 528 + i2 * 4) = pk2(k1[jj][0], k1[jj][1]); *(LAS unsigned*)(lds + KA + t * 528 + 256 + i2 * 4) = pk2(k2[jj][0], k2[jj][1]); }
      const int t0 = 2 * tq;
      *(LAS unsigned*)(lds + KAT + (2 * i2) * 144 + t0 * 2) = pk2(k1[0][0], k1[1][0]);
      *(LAS unsigned*)(lds + KAT + (2 * i2 + 1) * 144 + t0 * 2) = pk2(k1[0][1], k1[1][1]);
      *(LAS unsigned*)(lds + KAT + (128 + 2 * i2) * 144 + t0 * 2) = pk2(k2[0][0], k2[1][0]);
      *(LAS unsigned*)(lds + KAT + (128 + 2 * i2 + 1) * 144 + t0 * 2) = pk2(k2[0][1], k2[1][1]);
      unsigned z0 = 0u; asm volatile("" : "+v"(z0));
      *(LAS u32x4*)(lds + KAT + (tid >> 1) * 144 + 32 + (tid & 1) * 16) = (u32x4){z0, z0, z0, z0}; }
    __syncthreads();
    if (w == 0) {
        f32x4 acc = (f32x4){0.f, 0.f, 0.f, 0.f};
#pragma unroll
        for (int ks = 0; ks < 8; ++ks) acc = MFMA16(ldfrag(lds, KA + fr * 528 + (32 * ks + 8 * fq) * 2), ldfrag(lds, QA + fr * 528 + (32 * ks + 8 * fq) * 2), acc);
#pragma unroll
        for (int r = 0; r < 4; ++r) { const int ss = 4 * fq + r; acc[r] = (ss > fr) ? 0.f : acc[r] * __expf(lg * (float)(fr - ss)); }
        *(LAS u32x2*)(lds + PB + fr * 144 + 8 * fq) = pack4(acc[0], acc[1], acc[2], acc[3]);
        *(LAS u32x2*)(lds + PB + fr * 144 + 32 + 8 * fq) = (u32x2){0u, 0u};
    }
#pragma unroll 1
    for (int vs0 = 0; vs0 < 8; ++vs0) {
        int vs = vs0; asm volatile("" : "+s"(vs));
        f32x4 sacc[4];
#pragma unroll
        for (int m = 0; m < 4; ++m) sacc[m] = nxt[m];
        if (vs + 1 < 8) {
#pragma unroll
            for (int m = 0; m < 4; ++m)
#pragma unroll
                for (int r = 0; r < 4; ++r) nxt[m][r] = S0[(size_t)(16 * (ktb + m) + 4 * fq + r) * 256 + (vs + 1) * 32 + 16 * vi + fr]; }
#pragma unroll
        for (int m = 0; m < 4; ++m) *(LAS u32x2*)(lds + ST + (16 * vi + fr) * 528 + (16 * (ktb + m) + 4 * fq) * 2) = pack4(sacc[m][0], sacc[m][1], sacc[m][2], sacc[m][3]);
        { const int v = tid & 31, t = tid >> 5; float x = 0.f;
          if (t < 8) x = bf2f(Z[(size_t)(si.base + t) * NPAD + ZRV + h * 256 + vs * 32 + v]);
          const unsigned xb = pk2(x, 0.f) & 0xffffu, xd = pk2(x * __expf(lg * (float)(7 - (t & 7))), 0.f) & 0xffffu;
          *(LAS bf16_t*)(lds + VT + v * 144 + t * 2) = (bf16_t)xb; *(LAS bf16_t*)(lds + VT + v * 144 + 32 + t * 2) = 0;
          *(LAS bf16_t*)(lds + VDT + v * 144 + t * 2) = (bf16_t)(t < 8 ? xd : 0u); *(LAS bf16_t*)(lds + VDT + v * 144 + 32 + t * 2) = 0; }
        __syncthreads();
        if (w < 2) { f32x4 a1 = (f32x4){0.f, 0.f, 0.f, 0.f}, a2 = a1;
            a1 = MFMA16(ldfrag(lds, VT + (16 * vi + fr) * 144 + 16 * fq), ldfrag(lds, PB + fr * 144 + 16 * fq), a1);
#pragma unroll
            for (int ks = 0; ks < 8; ++ks) a2 = MFMA16(ldfrag(lds, ST + (16 * vi + fr) * 528 + (32 * ks + 8 * fq) * 2), ldfrag(lds, QA + fr * 528 + (32 * ks + 8 * fq) * 2), a2);
            const float qd = __expf(lg * (float)(fr + 1));
            if (fr < 8) *(u32x2*)(ORN + (size_t)(si.base + fr) * 1024 + h * 256 + vs * 32 + 16 * vi + 4 * fq) = pack4(a1[0] + qd * a2[0], a1[1] + qd * a2[1], a1[2] + qd * a2[2], a1[3] + qd * a2[3]); }
#pragma unroll
        for (int m = 0; m < 4; ++m) { const int kt = ktb + m; sacc[m] *= cdec;
            sacc[m] = MFMA16(ldfrag(lds, KAT + (16 * kt + fr) * 144 + 16 * fq), ldfrag(lds, VDT + (16 * vi + fr) * 144 + 16 * fq), sacc[m]);
#pragma unroll
            for (int r = 0; r < 4; ++r) Sout[(size_t)(16 * kt + 4 * fq + r) * 256 + vs * 32 + 16 * vi + fr] = sacc[m][r]; }
        __syncthreads();
    }
}
__device__ __forceinline__ void phase2(const Params& P, const Ctx& C, int l, int qi, int tmask) {
    volatile LAS unsigned* lctl = (volatile LAS unsigned*)(C.lds + LDS_CTL_OFF);
    constexpr int NT = 72 + 64 + 32 + 32 + 512 + 512 + 256;
    unsigned* qh = C.ctl + CW_Q + 64 * qi;
    __syncthreads();
    int t = C.bid;
    while (t < NT) {
        unsigned nxt = 0u; if (C.tid == 0) nxt = (unsigned)C.G + xb_add(qh, 1u);
        int ty, sq = 0, a0 = 0, a1 = 0; const int t2 = t - 72;
        if (t < 72) { ty = 6; a0 = t; }
        else if (t2 < 64) { ty = 0; sq = t2 >> 4; a0 = t2 & 15; }
        else if (t2 < 96) { const int u = t2 - 64; ty = 4; sq = u >> 3; a0 = (u >> 1) & 3; a1 = u & 1; }
        else if (t2 < 128) { const int u = t2 - 96; ty = 3; sq = u >> 3; a0 = u & 7; }
        else if (t2 < 384) { const int u = t2 - 128; ty = 2; sq = 4 + (u >> 1); a0 = u & 1; }
        else if (t2 < 896) { const int u = t2 - 384; ty = 1; sq = 4 + (u >> 2); a0 = u & 3; }
        else { const int u = t2 - 896; ty = 5; sq = 4 + (u >> 2); a0 = u & 3; }
        if (ty == 0) { if (tmask & 1) rwkv_task(P, C, l, sq, a0); }
        else if (ty == 1) { if (tmask & 2) ret_s_task(P, C, l, sq, a0); }
        else if (ty == 2) { if (tmask & 4) hgrn_task(P, C, l, sq, a0); }
        else if (ty == 3) { if (tmask & 4) hgrn_b_task(P, C, l, sq, a0); }
        else if (ty == 4) { if (tmask & 2) ret_b_task(P, C, l, sq, a0, a1); }
        else if (ty == 5) { if (tmask & 1) rwkv_s_task(P, C, l, sq, a0); }
        else {
            pg8::Gemm g{WSP(bf16_t, WS_XB), WSP(bf16_t, WS_WIN) + (size_t)l * NPAD * 2048, M, NPAD, 2048}; pg8::SingleOrder S1{a0 < 64 ? 8 * (a0 >> 4) + (a0 & 7) : 32 + (a0 & 3), 71 + (a0 < 64 ? (a0 >> 3) & 1 : (a0 >> 2) & 1)};
            EpiZ E{WSP(bf16_t, WS_Z), WSP(float, WS_SS) + (size_t)l * M};
            pg8::gemm_phase<EpiZ, pg8::SingleOrder>(C.lds, g, S1, E); }
        __syncthreads();
        if (C.tid == 0) lctl[4] = nxt;
        __syncthreads();
        t = (int)lctl[4];
    }
}

template <int BR>
__device__ __forceinline__ void p2c_branch(const Params& P, const Ctx& C, int l, int lane, int gw, int NGW) {
    const int c0 = 16 * lane;
    const bf16_t* SRC = (BR == 0 ? WSP(bf16_t, WS_OHG) : BR == 1 ? WSP(bf16_t, WS_YRW) : WSP(bf16_t, WS_ORN)) + c0;
    const bf16_t* GP = WSP(bf16_t, WS_Z) + ZG + BR * 1024 + c0;
    const bf16_t* VP = WSP(bf16_t, WS_VB) + (size_t)l * M * 1024 + c0;
    const float* BON = WSP(float, WS_BONUS) + (lane >> 2);
    bf16_t* YS = WSP(bf16_t, WS_YS) + (size_t)BR * M * 1024 + c0;
    float k0[16], k1[16];
    if (BR == 0) { const float* hn = P.in[11] + l * 128 + (c0 & 127);
#pragma unroll
        for (int j = 0; j < 16; ++j) k0[j] = hn[j]; }
    if (BR == 1) { const float* lw = P.in[23] + l * 1024 + c0; const float* lbb = P.in[24] + l * 1024 + c0;
#pragma unroll
        for (int j = 0; j < 16; ++j) { k0[j] = lw[j]; k1[j] = lbb[j]; } }
    u32x4 cs0, cs1, cg0, cg1, cv0, cv1; float cb = 0.f;
    { const int g = gw; const bf16_t* src = SRC + (size_t)g * 1024; const bf16_t* gp = GP + (size_t)g * NPAD;
      cs0 = *(const u32x4*)src; cs1 = *(const u32x4*)(src + 8); cg0 = *(const u32x4*)gp; cg1 = *(const u32x4*)(gp + 8);
      if (BR == 1) { const bf16_t* vp = VP + (size_t)g * 1024; cv0 = *(const u32x4*)vp; cv1 = *(const u32x4*)(vp + 8); cb = BON[(size_t)g * 16]; } }
#pragma unroll 1
    for (int g = gw; g < M; g += NGW) {
        const int gn = (g + NGW < M) ? g + NGW : g;
        u32x4 ns0, ns1, ng0, ng1, nv0, nv1; float nb = 0.f;
        { const bf16_t* src = SRC + (size_t)gn * 1024; const bf16_t* gp = GP + (size_t)gn * NPAD;
          ns0 = *(const u32x4*)src; ns1 = *(const u32x4*)(src + 8); ng0 = *(const u32x4*)gp; ng1 = *(const u32x4*)(gp + 8);
          if (BR == 1) { const bf16_t* vp = VP + (size_t)gn * 1024; nv0 = *(const u32x4*)vp; nv1 = *(const u32x4*)(vp + 8); nb = BON[(size_t)gn * 16]; } }
        __builtin_amdgcn_sched_barrier(0);
        float x[16], gt[16], y[16];
        { float a[8], b[8]; unpack8(cs0, a); unpack8(cs1, b);
#pragma unroll
            for (int j = 0; j < 8; ++j) { x[j] = a[j]; x[8 + j] = b[j]; }
            unpack8(cg0, a); unpack8(cg1, b);
#pragma unroll
            for (int j = 0; j < 8; ++j) { gt[j] = siluf(a[j]); gt[8 + j] = siluf(b[j]); } }
        if (BR == 0) { float ss = 0.f;
#pragma unroll
            for (int j = 0; j < 16; ++j) ss += x[j] * x[j];
            ss = red8(ss); const float rs = rsqrtf(ss * (1.f / 128.f) + EPS);
#pragma unroll
            for (int j = 0; j < 16; ++j) y[j] = x[j] * rs * k0[j] * gt[j]; }
        else if (BR == 1) { float sm = 0.f;
#pragma unroll
            for (int j = 0; j < 16; ++j) sm += x[j];
            sm = red4(sm); const float mu = sm * (1.f / 64.f); float sv = 0.f;
#pragma unroll
            for (int j = 0; j < 16; ++j) { const float d = x[j] - mu; sv += d * d; }
            sv = red4(sv); const float rs = rsqrtf(sv * (1.f / 64.f) + 64e-5f);
            float vv[16]; { float a[8], b[8]; unpack8(cv0, a); unpack8(cv1, b);
#pragma unroll
                for (int j = 0; j < 8; ++j) { vv[j] = a[j]; vv[8 + j] = b[j]; } }
#pragma unroll
            for (int j = 0; j < 16; ++j) y[j] = ((x[j] - mu) * rs * k0[j] + k1[j] + cb * vv[j]) * gt[j]; }
        else { float ss = 0.f;
#pragma unroll
            for (int j = 0; j < 16; ++j) ss += x[j] * x[j];
            ss = red16(ss); const float rs = rsqrtf(ss * (1.f / 256.f) + EPS);
#pragma unroll
            for (int j = 0; j < 16; ++j) y[j] = x[j] * rs * gt[j]; }
        u32x4 o0, o1; o0.x = pk2(y[0], y[1]); o0.y = pk2(y[2], y[3]); o0.z = pk2(y[4], y[5]); o0.w = pk2(y[6], y[7]); o1.x = pk2(y[8], y[9]); o1.y = pk2(y[10], y[11]); o1.z = pk2(y[12], y[13]); o1.w = pk2(y[14], y[15]);
        bf16_t* dst = YS + (size_t)g * 1024; *(u32x4*)dst = o0; *(u32x4*)(dst + 8) = o1;
        __builtin_amdgcn_sched_barrier(0);
        cs0 = ns0; cs1 = ns1; cg0 = ng0; cg1 = ng1; if (BR == 1) { cv0 = nv0; cv1 = nv1; cb = nb; }
    }
}
__device__ __forceinline__ void phase2c(const Params& P, const Ctx& C, int l) {
    int lane = C.lane; asm volatile("" : "+v"(lane));
    const int gw = C.bid * 8 + C.wave, NGW = C.G * 8;
    p2c_branch<0>(P, C, l, lane, gw, NGW);
    asm volatile("" : "+v"(lane));
    p2c_branch<1>(P, C, l, lane, gw, NGW);
    asm volatile("" : "+v"(lane));
    p2c_branch<2>(P, C, l, lane, gw, NGW);
}

template <int L>
__device__ __forceinline__ void phase6_t(const Params& P, const Ctx& C) {
    constexpr int l = L;
    int lane = C.lane; asm volatile("" : "+v"(lane));
    const int gw = C.bid * 8 + C.wave, NGW = C.G * 8;
    const float* np = P.in[27] + l * 2048 + 4 * lane; const float* ssu = WSP(float, WS_SS) + (size_t)(2 + l) * M;
    const bf16_t* U = WSP(bf16_t, WS_U) + 4 * lane; bf16_t* XN = WSP(bf16_t, WS_XNB) + 4 * lane;
    f32x4 gg[8];
#pragma unroll
    for (int j = 0; j < 8; ++j) gg[j] = *(const f32x4*)(np + 256 * j);
    f32x4 cx[L == 0 ? 8 : 1]; u32x2 cxb[L == 0 ? 1 : 8]; u32x2 cu[8]; float css;
    { const int m = gw; css = ssu[m];
      if (L == 0) { const float* xr = ((m < MP) ? P.in[0] + (size_t)m * 2048 : P.in[1] + (size_t)(m - MP) * 2048) + 4 * lane;
#pragma unroll
          for (int j = 0; j < 8; ++j) cx[L == 0 ? j : 0] = *(const f32x4*)(xr + 256 * j); }
      else { const bf16_t* xr = WSP(bf16_t, WS_XB) + (size_t)m * 2048 + 4 * lane;
#pragma unroll
          for (int j = 0; j < 8; ++j) cxb[L == 0 ? 0 : j] = *(const u32x2*)(xr + 256 * j); }
#pragma unroll
      for (int j = 0; j < 8; ++j) cu[j] = *(const u32x2*)(U + (size_t)m * 2048 + 256 * j); }
#pragma unroll 1
    for (int m = gw; m < M; m += NGW) {
        const int mn = (m + NGW < M) ? m + NGW : m;
        f32x4 nx[L == 0 ? 8 : 1]; u32x2 nxb[L == 0 ? 1 : 8]; u32x2 nu[8]; float nss = ssu[mn];
        if (L == 0) { const float* xr = ((mn < MP) ? P.in[0] + (size_t)mn * 2048 : P.in[1] + (size_t)(mn - MP) * 2048) + 4 * lane;
#pragma unroll
            for (int j = 0; j < 8; ++j) nx[L == 0 ? j : 0] = *(const f32x4*)(xr + 256 * j); }
        else { const bf16_t* xr = WSP(bf16_t, WS_XB) + (size_t)mn * 2048 + 4 * lane;
#pragma unroll
            for (int j = 0; j < 8; ++j) nxb[L == 0 ? 0 : j] = *(const u32x2*)(xr + 256 * j); }
#pragma unroll
        for (int j = 0; j < 8; ++j) nu[j] = *(const u32x2*)(U + (size_t)mn * 2048 + 256 * j);
        __builtin_amdgcn_sched_barrier(0);
        const float rs = rsqrtf(css * (1.f / 2048.f) + EPS);
        bf16_t* xb = XN + (size_t)m * 2048;
#pragma unroll
        for (int j = 0; j < 8; ++j) { const f32x4 g = gg[j]; float u[4]; unpack4(cu[j], u);
            f32x4 x; if (L == 0) x = cx[L == 0 ? j : 0]; else { float t4[4]; unpack4(cxb[L == 0 ? 0 : j], t4); x = (f32x4){t4[0], t4[1], t4[2], t4[3]}; }
            *(u32x2*)(xb + 256 * j) = pack4(x[0] + u[0] * rs * g[0], x[1] + u[1] * rs * g[1], x[2] + u[2] * rs * g[2], x[3] + u[3] * rs * g[3]); }
        __builtin_amdgcn_sched_barrier(0);
        css = nss;
#pragma unroll
        for (int j = 0; j < 8; ++j) { cu[j] = nu[j]; if (L == 0) cx[L == 0 ? j : 0] = nx[L == 0 ? j : 0]; else cxb[L == 0 ? 0 : j] = nxb[L == 0 ? 0 : j]; }
    }
}
__device__ __forceinline__ void phase6(const Params& P, const Ctx& C, int l) { if (l == 0) phase6_t<0>(P, C); else phase6_t<1>(P, C); }

__global__ void __launch_bounds__(NTHREADS, 2) fwd_megakernel(Params p) {
    extern __shared__ __attribute__((aligned(16))) unsigned char lds_raw[];
    Ctx C;
    C.out = p.out; C.ws = p.ws;
    C.lds = (LAS unsigned char*)lds_raw;
    C.tid = threadIdx.x; C.lane = C.tid & 63; C.wave = __builtin_amdgcn_readfirstlane(C.tid >> 6); C.G = gridDim.x; C.bid = blockIdx.x;
    C.ctl = (unsigned*)(p.ws + WS_CTL);
    volatile LAS unsigned* lctl = (volatile LAS unsigned*)(C.lds + LDS_CTL_OFF);
    if (C.tid < 64) lctl[C.tid] = 0u;
    __syncthreads();
    XcdBarrier bar = xcd_barrier_post(C.ctl, lctl);
    cg::grid_group grid = cg::this_grid();
#ifndef DUPX
#define DUPX -1
#endif
#define NREP(id) ((DUPX) == (id) ? 2 : 1)
#define XBAR() xcd_barrier(bar)
    for (int rep = 0; rep < NREP(0); ++rep) { if (rep) __syncthreads(); phase0(p, C); }
    grid.sync();

#pragma unroll 1
    for (int l = 0; l < 2; ++l) {
        int bidl = C.bid, Gl = C.G; asm volatile("" : "+s"(bidl), "+s"(Gl)); Ctx CL = C; CL.bid = bidl; CL.G = Gl;
        for (int rep = 0; rep < NREP(1); ++rep) { if (rep) XBAR();
          pg8::Gemm g{WSPL(bf16_t, WS_XB), WSPL(bf16_t, WS_WIN) + (size_t)l * NPAD * 2048, M, 71 * 256, 2048}; pg8::StaticOrder S; S.init(M, 71 * 256, CL.G, CL.bid);
          EpiZ E{WSPL(bf16_t, WS_Z), WSPL(float, WS_SS) + (size_t)l * M};
          pg8::gemm_phase<EpiZ, pg8::StaticOrder>(CL.lds, g, S, E); }
        XBAR();
        for (int rep = 0; rep < NREP(2); ++rep) { if (rep) XBAR();
            volatile LAS unsigned* lq = (volatile LAS unsigned*)(CL.lds + LDS_CTL_OFF);
            unsigned* qh = CL.ctl + CW_Q + 64 * (2 + l + 8 * rep);
            __syncthreads();
            int it = CL.bid;
            while (it < 576 + 512 + 1024) {
                unsigned nxt = 0u; if (CL.tid == 0) nxt = (unsigned)CL.G + xb_add(qh, 1u);
                if (it < 576) { const int t = it < 64 ? 512 + it : it - 64;
                    if (t < 512) { if (l == 0) p2a_item<0, false>(p, CL, t); else p2a_item<1, false>(p, CL, t); } else { if (l == 0) p2a_item<0, true>(p, CL, t); else p2a_item<1, true>(p, CL, t); }
                    int lane2 = CL.lane; asm volatile("" : "+v"(lane2)); LAS unsigned char* wl = CL.lds + CL.wave * 13312;
                    for (int hh = 0; hh < 2; ++hh) { const int hd = 2 * CL.wave + hh;
                        if (t < 512) rwkv_prep_item(p, CL, l, hd * 640 + t, wl, lane2);
                        else { rwkv_prep_item(p, CL, l, hd * 640 + 512 + 2 * (t - 512), wl, lane2); rwkv_prep_item(p, CL, l, hd * 640 + 512 + 2 * (t - 512) + 1, wl, lane2); } } }
                else if (it < 576 + 512) ret_a_item(p, CL, l, it - 576);
                else hgrn_a_item(p, CL, l, it - 576 - 512);
                __syncthreads();
                if (CL.tid == 0) lq[4] = nxt;
                __syncthreads();
                it = (int)lq[4];
            }
        }
        XBAR();
        for (int rep = 0; rep < NREP(4); ++rep) { if (rep) XBAR(); phase2(p, CL, l, l + 8 * rep, 7); }
        XBAR();
        for (int rep = 0; rep < NREP(5); ++rep) phase2c(p, CL, l);
        XBAR();
        for (int rep = 0; rep < NREP(6); ++rep) { if (rep) XBAR();
          { pg8::Gemm g{WSPL(bf16_t, WS_YS), WSPL(bf16_t, WS_WBR) + (size_t)l * 3 * 2048 * 1024, 3 * M, 3 * 2048, 1024}; pg8::BranchOrder S; S.s.init(M, 2048, CL.G, CL.bid);
            EpiBranch E{WSPL(bf16_t, WS_Z), WSPL(bf16_t, WS_MB)};
            pg8::gemm_phase<EpiBranch, pg8::BranchOrder>(CL.lds, g, S, E);
            pg8::ExtraOrder S2; S2.s.init(M, 2048, CL.G, CL.bid); EpiBranchAtomic E2{WSPL(bf16_t, WS_Z), WSPL(bf16_t, WS_RWP)};
            if (rep == 0) pg8::gemm_phase<EpiBranchAtomic, pg8::ExtraOrder>(CL.lds, g, S2, E2); }
          if (rep == 0 && CL.bid < 160) {
            pg8::Gemm g2{WSPL(bf16_t, WS_PB) + (size_t)l * M * 256, WSPL(bf16_t, WS_WUP) + (size_t)l * 2048 * 256, M, 2048, 256}; pg8::StaticOrder S3; S3.init(M, 2048, 160, CL.bid);
            EpiSS E3{WSPL(bf16_t, WS_ER), WSPL(float, WS_SS) + (size_t)(4 + l) * M};
            pg8::gemm_phase<EpiSS, pg8::StaticOrder>(CL.lds, g2, S3, E3);
            if (l == 0) conv_layer_items(p, CL, 0, 21760, 25856, CL.bid * 8 + CL.wave, 160 * 8); }
        }
        XBAR();
        { int tz = CL.tid; asm volatile("" : "+v"(tz)); pg8::StaticOrder S; S.init(M, 2048, CL.G, 0); const bf16_t* sp = WSPL(bf16_t, WS_RWP); bf16_t* Mb = WSPL(bf16_t, WS_MB);
          for (int i = CL.bid * NTHREADS + tz; i < 32 * 65536 / 8; i += CL.G * NTHREADS) { const int t = i >> 13, r = (i >> 5) & 255, c8 = (i & 31) * 8; pg8::Unit u; S.tile(256 + t, u);
              float a[8], b[8], c[8];
              unpack8(*(const u32x4*)(sp + (size_t)t * 65536 + r * 256 + c8), a); unpack8(*(const u32x4*)(sp + (size_t)(32 + t) * 65536 + r * 256 + c8), b); unpack8(*(const u32x4*)(sp + (size_t)(64 + t) * 65536 + r * 256 + c8), c);
              u32x4 w; w.x = pk2(a[0] + b[0] + c[0], a[1] + b[1] + c[1]); w.y = pk2(a[2] + b[2] + c[2], a[3] + b[3] + c[3]); w.z = pk2(a[4] + b[4] + c[4], a[5] + b[5] + c[5]); w.w = pk2(a[6] + b[6] + c[6], a[7] + b[7] + c[7]);
              *(u32x4*)(Mb + (size_t)(u.pm * 256 + r) * 2048 + u.pn * 256 + c8) = w; } }
        XBAR();
        for (int rep = 0; rep < NREP(7); ++rep) { if (rep) XBAR();
          pg8::Gemm g{WSPL(bf16_t, WS_MB), WSPL(bf16_t, WS_WOUT) + (size_t)l * 2048 * 2048, M, 2048, 2048}; pg8::StaticOrder S; S.init(M, 2048, CL.G, CL.bid);
          EpiSS E{WSPL(bf16_t, WS_U), WSPL(float, WS_SS) + (size_t)(rep ? 6 : 2 + l) * M};
          pg8::gemm_phase<EpiSS, pg8::StaticOrder>(CL.lds, g, S, E);
          if (l == 0 && rep == 0 && CL.bid >= 32) conv_layer_items(p, CL, 1, 0, CONV_SPLIT, (CL.bid - 32) * 8 + CL.wave, (CL.G - 32) * 8); }
        XBAR();
        for (int rep = 0; rep < NREP(8); ++rep) phase6(p, CL, l);
        XBAR();
        for (int rep = 0; rep < NREP(9); ++rep) { if (rep) XBAR();
          pg8::Gemm g{WSPL(bf16_t, WS_XNB), WSPL(bf16_t, WS_WGATE) + (size_t)l * 2048 * 2048, M, 2048, 2048}; pg8::StaticOrder S; S.init(M, 2048, CL.G, CL.bid);
          EpiGate E{WSPL(bf16_t, WS_XNB), WSPL(bf16_t, WS_ER), WSPL(float, WS_SS) + (size_t)(4 + l) * M, p.in[29] + l * 2048,
                    l == 0 ? nullptr : CL.out + OFF_Y, l == 0 ? WSPL(bf16_t, WS_XB) : nullptr, l == 0 ? WSPL(float, WS_SS) + (rep ? 6 : 1) * M : nullptr};
          pg8::gemm_phase<EpiGate, pg8::StaticOrder>(CL.lds, g, S, E);
          if (l == 0 && rep == 0 && CL.bid >= 32) conv_layer_items(p, CL, 1, CONV_SPLIT, CONV_ITEMS, (CL.bid - 32) * 8 + CL.wave, (CL.G - 32) * 8); }
        if (l == 0) XBAR();
    }
}

extern "C" void kernel_launch(void* const* d_in, const int* in_sizes, int n_in, void* d_out, int out_size, void* d_ws, size_t ws_size, hipStream_t stream) {
    static int grid_blocks = 0;
    if (!grid_blocks) {
        int dev = 0, cus = 0, per_cu = 0;
        (void)hipGetDevice(&dev);
        (void)hipDeviceGetAttribute(&cus, hipDeviceAttributeMultiprocessorCount, dev);
        (void)hipFuncSetAttribute((const void*)fwd_megakernel, hipFuncAttributeMaxDynamicSharedMemorySize, LDS_BYTES);
        (void)hipOccupancyMaxActiveBlocksPerMultiprocessor(&per_cu, (const void*)fwd_megakernel, NTHREADS, LDS_BYTES);
        if (per_cu < 1) { fprintf(stderr, "occupancy query says %d blocks/CU\n", per_cu); per_cu = 1; }
        if (per_cu > 1) per_cu = 1;
        grid_blocks = cus * per_cu;
        if (ws_size < WS_END || n_in != 31 || out_size != 140846592) fprintf(stderr, "kernel_launch: unexpected sizes ws %zu (need %zu) n_in %d out %d\n", ws_size, (size_t)WS_END, n_in, out_size);
    }
    (void)hipMemsetAsync((char*)d_ws + WS_CTL, 0, CTL_BYTES, stream);
    Params p{};
    for (int i = 0; i < 31; ++i) p.in[i] = (const float*)d_in[i];
    p.out = (float*)d_out; p.ws = (unsigned char*)d_ws;
    void* args[] = {&p};
    hipError_t e = hipLaunchCooperativeKernel((const void*)fwd_megakernel, dim3(grid_blocks), dim3(NTHREADS), args, LDS_BYTES, stream);
    if (e != hipSuccess) fprintf(stderr, "cooperative launch failed: %s (grid %d)\n", hipGetErrorString(e), grid_blocks);
}
```

```cpp
#include <hip/hip_runtime.h>
#include <hip/hip_cooperative_groups.h>
#include <cstdio>
namespace cg = cooperative_groups;

#define LAS __attribute__((address_space(3)))
typedef unsigned short bf16_t;
typedef short bf16x8 __attribute__((ext_vector_type(8)));
typedef float f32x4 __attribute__((ext_vector_type(4)));
typedef float f32x2 __attribute__((ext_vector_type(2)));
typedef unsigned u32x4 __attribute__((ext_vector_type(4)));
typedef unsigned u32x2 __attribute__((ext_vector_type(2)));

constexpr int NTHREADS = 512;
constexpr int LDS_MAIN = 143360;
constexpr int LDS_CTL_OFF = LDS_MAIN;
constexpr int LDS_BYTES = LDS_MAIN + 256;

constexpr int M = 9216, MP = 8192, D = 2048, NPAD = 18688, DIN = 18624;
constexpr int ZHQ = 0, ZHF = 1024, ZHI = 2048, ZR = 3072, ZK = 4096, ZV = 5120, ZWL = 6144, ZAL = 6240, ZRQ = 6400, ZRK = 7424, ZRV = 8448, ZG = 9472, ZM = 12544;
constexpr float EPS = 1e-6f;
constexpr size_t OFF_Y = 0, OFF_HGP = 18874368, OFF_HGS = 19922944, OFF_RWP = 53477376, OFF_RWS = 54001664, OFF_SHP = 70778880, OFF_SHS = 70804992, OFF_RNP = 71640576, OFF_RNS = 73737728;

constexpr size_t WS_CTL = 0, CTL_BYTES = 65536;
constexpr size_t WS_WIN = 65536;                                   constexpr size_t SZ_WIN = (size_t)2 * NPAD * 2048 * 2;
constexpr size_t WS_WBR = WS_WIN + SZ_WIN;                         constexpr size_t SZ_WBR = (size_t)6 * 2048 * 1024 * 2;
constexpr size_t WS_WOUT = WS_WBR + SZ_WBR;                        constexpr size_t SZ_WSQ = (size_t)2 * 2048 * 2048 * 2;
constexpr size_t WS_WGATE = WS_WOUT + SZ_WSQ;
constexpr size_t WS_WUP = WS_WGATE + SZ_WSQ;                       constexpr size_t SZ_WUP = (size_t)2 * 2048 * 256 * 2;
constexpr size_t WS_W2T = WS_WUP + SZ_WUP;                         constexpr size_t SZ_LORA = (size_t)2 * 1024 * 96 * 2;
constexpr size_t WS_A2T = WS_W2T + SZ_LORA;
constexpr size_t WS_V1T = WS_A2T + SZ_LORA;                        constexpr size_t SZ_V1 = (size_t)64 * 1024 * 2;
constexpr size_t WS_V2T = WS_V1T + SZ_V1;
constexpr size_t WS_ROPE = WS_V2T + SZ_V1;                         constexpr size_t SZ_ROPE = (size_t)2056 * 128 * 2 * 4;
constexpr size_t WS_XB = WS_ROPE + SZ_ROPE;                        constexpr size_t SZ_ACT2 = (size_t)M * 2048 * 2;
constexpr size_t WS_PB = WS_XB + SZ_ACT2;                          constexpr size_t SZ_PB = (size_t)2 * M * 256 * 2;
constexpr size_t WS_SS = WS_PB + SZ_PB;                            constexpr size_t SZ_SS = (size_t)7 * M * 4;
constexpr size_t WS_XL1 = WS_SS + SZ_SS;                           constexpr size_t SZ_ACT4 = (size_t)M * 2048 * 4;
constexpr size_t WS_Z = WS_XL1 + SZ_ACT4;                          constexpr size_t SZ_Z = (size_t)M * NPAD * 2;
constexpr size_t WS_DW = WS_Z + SZ_Z;                              constexpr size_t SZ_C4 = (size_t)M * 1024 * 4;
constexpr size_t WS_R = WS_DW + SZ_C4;                             constexpr size_t SZ_C2 = (size_t)M * 1024 * 2;
constexpr size_t WS_KK = WS_R + SZ_C2;
constexpr size_t WS_BB = WS_KK + SZ_C2;
constexpr size_t WS_KP = WS_BB + SZ_C2;
constexpr size_t WS_VB = WS_KP + SZ_C2;
constexpr size_t WS_BONUS = WS_VB + 2 * SZ_C2;                     constexpr size_t SZ_BONUS = (size_t)M * 16 * 4;
constexpr size_t WS_YRW = WS_BONUS + SZ_BONUS;
constexpr size_t WS_OHG = WS_YRW + SZ_C2;
constexpr size_t WS_ORN = WS_OHG + SZ_C2;
constexpr size_t WS_YS = WS_ORN + SZ_C2;                           constexpr size_t SZ_YS = (size_t)3 * M * 1024 * 2;
constexpr size_t WS_MB = WS_YS + SZ_YS;
constexpr size_t WS_ER = WS_MB + SZ_ACT2;
constexpr size_t WS_RWP = WS_ER + SZ_ACT2;                         constexpr size_t RWREC = 13056; constexpr size_t SZ_RWP = (size_t)10240 * RWREC;
constexpr size_t WS_END = WS_RWP + SZ_RWP;
constexpr size_t WS_HREC = WS_YS;
constexpr size_t WS_RQA = WS_XL1;
static_assert((size_t)512 * 33792 <= SZ_ACT4, "rqa overflow");
static_assert(WS_HREC + (size_t)1024 * 50688 <= WS_ER, "hrec alias must not reach e_raw (written in the first GEMM phase's tail)");
static_assert((size_t)512 * 131072 <= (size_t)18874368 * 4, "L records exceed the y region");
constexpr size_t WS_U = WS_Z;
constexpr size_t WS_XNF = WS_U + SZ_ACT2;
constexpr size_t WS_XNB = WS_XNF + SZ_ACT4;
static_assert(WS_XNB + SZ_ACT2 <= WS_Z + SZ_Z, "alias overflow");
constexpr int CW_Q = 4096;

typedef __bf16 bf16v2 __attribute__((ext_vector_type(2)));
__device__ __forceinline__ unsigned pk2(float lo, float hi) { bf16v2 v; v.x = (__bf16)lo; v.y = (__bf16)hi; return __builtin_bit_cast(unsigned, v); }
__device__ __forceinline__ float bflo(unsigned w) { return __uint_as_float(w << 16); }
__device__ __forceinline__ float bfhi(unsigned w) { return __uint_as_float(w & 0xffff0000u); }
__device__ __forceinline__ float bf2f(bf16_t b) { return __uint_as_float(((unsigned)b) << 16); }
__device__ __forceinline__ float rcpf_(float x) { return __builtin_amdgcn_rcpf(x); }
__device__ __forceinline__ float sigm(float x) { return rcpf_(1.f + __expf(-x)); }
__device__ __forceinline__ float siluf(float x) { return x * rcpf_(1.f + __expf(-x)); }
#define LDS_WAIT() asm volatile("s_waitcnt lgkmcnt(0)" ::: "memory")
template <int CTRL> __device__ __forceinline__ float dppf(float v) { return __int_as_float(__builtin_amdgcn_update_dpp(0, __float_as_int(v), CTRL, 0xF, 0xF, true)); }
__device__ __forceinline__ float red4(float v) { v += dppf<0xB1>(v); v += dppf<0x4E>(v); return v; }
__device__ __forceinline__ float red8(float v) { v = red4(v); v += dppf<0x141>(v); return v; }
__device__ __forceinline__ float red16(float v) { v = red8(v); v += dppf<0x140>(v); return v; }
__device__ __forceinline__ float wave_sum(float v) {
#pragma unroll
    for (int o = 1; o < 64; o <<= 1) v += __shfl_xor(v, o);
    return v;
}
__device__ __forceinline__ bf16x8 ldfrag(const LAS unsigned char* base, int off) { return *(const LAS bf16x8*)(base + off); }
#define MFMA16(a, b, c) __builtin_amdgcn_mfma_f32_16x16x32_bf16((a), (b), (c), 0, 0, 0)

#define XB_TMO      128
#define XB_XCNT(j)  (256  + 64 * (j))
#define XB_XSUB(j)  (1280 + 64 * (j))
#define XB_XGEN(j)  (2304 + 64 * (j))
#define XB_TOP      3328
#define XB_TOPGEN   3392
#define XCD_BAR_WORDS 3456
#define XB_SPIN_CAP (1u << 22)
__device__ __forceinline__ unsigned xb_ld(unsigned* p)              { return __hip_atomic_load(p, __ATOMIC_RELAXED, __HIP_MEMORY_SCOPE_AGENT); }
__device__ __forceinline__ unsigned xb_add(unsigned* p, unsigned v) { return __hip_atomic_fetch_add(p, v, __ATOMIC_RELAXED, __HIP_MEMORY_SCOPE_AGENT); }
__device__ __forceinline__ unsigned xb_xcc_id() { return (unsigned)__builtin_amdgcn_s_getreg((3 << 11) | 20) & 0xFu; }
#define XB_SPIN(cond, bar) do { unsigned _sp = 0; while (cond) { __builtin_amdgcn_s_sleep(1); \
    if ((++_sp & 255u) == 0u) { if (xb_ld(&(bar)[XB_TMO])) break; if (_sp > XB_SPIN_CAP) { atomicAdd(&(bar)[XB_TMO], 1u); break; } } } } while (0)
struct XcdBarrier { unsigned* bar; unsigned x; volatile LAS unsigned* st; };
__device__ __forceinline__ XcdBarrier xcd_barrier_post(unsigned* bar, volatile LAS unsigned* st) {
    XcdBarrier b; b.bar = bar; b.x = xb_xcc_id(); b.st = st;
    if (threadIdx.x == 0) (void)xb_add(&bar[XB_XCNT(b.x)], 1u);
    return b;
}
__device__ __forceinline__ void xcd_barrier_complete(unsigned* bar, unsigned x, unsigned& nloc, unsigned& nx) {
    const unsigned G = gridDim.x * gridDim.y * gridDim.z;
    unsigned sum, cnt, mine, sp = 0u;
    for (;;) {
        sum = 0u; cnt = 0u; mine = 0u;
#pragma unroll
        for (unsigned j = 0; j < 16; ++j) { const unsigned c = xb_ld(&bar[XB_XCNT(j)]); sum += c; cnt += (c > 0u) ? 1u : 0u; mine = (j == x) ? c : mine; }
        if (sum == G) break;
        __builtin_amdgcn_s_sleep(1);
        if ((++sp & 255u) == 0u) { if (xb_ld(&bar[XB_TMO])) break; if (sp > XB_SPIN_CAP) { atomicAdd(&bar[XB_TMO], 1u); break; } }
    }
    nloc = mine > 0u ? mine : 1u; nx = cnt > 0u ? cnt : 1u;
}
__device__ __forceinline__ void xcd_barrier(const XcdBarrier& b) {
    asm volatile("s_waitcnt vmcnt(0)" ::: "memory");
    __syncthreads();
    if (threadIdx.x == 0) {
        unsigned* bar = b.bar;
        __builtin_amdgcn_s_waitcnt(0);
        unsigned nloc = b.st[0], nx = b.st[1];
        if (nloc == 0u) { xcd_barrier_complete(bar, b.x, nloc, nx); b.st[0] = nloc; b.st[1] = nx; }
        const unsigned old = xb_add(&bar[XB_XSUB(b.x)], 1u);
        const unsigned gen = old / nloc;
        if (old + 1u == (gen + 1u) * nloc) {
            __builtin_amdgcn_fence(__ATOMIC_RELEASE, "agent");
            asm volatile("s_waitcnt vmcnt(0)" ::: "memory");
            const unsigned og = xb_add(&bar[XB_TOP], 1u);
            const unsigned tg = og / nx;
            if (og + 1u == (tg + 1u) * nx) xb_add(&bar[XB_TOPGEN], 1u);
            else XB_SPIN(xb_ld(&bar[XB_TOPGEN]) == tg, bar);
            __builtin_amdgcn_fence(__ATOMIC_ACQUIRE, "agent");
            xb_add(&bar[XB_XGEN(b.x)], 1u);
            asm volatile("s_waitcnt vmcnt(0)" ::: "memory");
        } else {
            XB_SPIN(xb_ld(&bar[XB_XGEN(b.x)]) == gen, bar);
            __builtin_amdgcn_fence(__ATOMIC_ACQUIRE, "agent");
            asm volatile("s_waitcnt vmcnt(0)" ::: "memory");
        }
    }
    __syncthreads();
}

namespace pg8 {
#define PG8_LAS __attribute__((address_space(3)))
constexpr int BM = 256, BK = 64, HALF = 128, HTB = HALF * BK * 2, STAGE_BYTES = 8 * HTB, NXCD = 8, WGM = 8;
__host__ __device__ __forceinline__ int lds_byte(int r, int c) { const int st = (r >> 4) * 2 + (c >> 5), rr = r & 15, cc = c & 31, ob = rr * 64 + cc * 2; return st * 1024 + (ob ^ (((ob >> 9) & 1) << 5)); }
__host__ __device__ __forceinline__ void stage_rc(int b, int& R, int& C) { const int st = b / 1024, sb = b % 1024, swz = sb ^ (((sb >> 9) & 1) << 5); R = (st >> 1) * 16 + swz / 64; C = (st & 1) * 32 + (swz % 64) / 2; }
__host__ __device__ __forceinline__ int perm32(int rho) { const int n = rho >> 4, i = rho & 15; return 8 * (i >> 2) + 4 * n + (i & 3); }
struct Unit { int pm, pn, fl, ko; };
struct Gemm { const bf16_t* A; const bf16_t* Bt; int M, N, K, ld; };
struct StaticOrder {
    int nM, nN, nwg, G, c;
    __host__ __device__ void init(int M_, int N_, int G_, int c_) { nM = M_ / BM; nN = N_ / BM; nwg = nM * nN; G = G_; c = c_; }
    __host__ __device__ __forceinline__ bool tile(long L, Unit& u) const {
        if (L >= nwg) return false;
        int wgid = (int)L; { const int q = nwg / NXCD, r = nwg % NXCD, xcd = wgid % NXCD, off = wgid / NXCD; wgid = (xcd < r ? xcd * (q + 1) : r * (q + 1) + (xcd - r) * q) + off; }
        const int nig = WGM * nN, gid = wgid / nig, fm = gid * WGM, gsz = (nM - fm) < WGM ? (nM - fm) : WGM;
        u.pm = fm + ((wgid % nig) % gsz); u.pn = (wgid % nig) / gsz; u.fl = 0; u.ko = 0; return true;
    }
    __host__ __device__ __forceinline__ bool next(int i, Unit& u) const { return tile((long)i * G + c, u); }
    __device__ __forceinline__ void a_ready(const Unit&) const {}
    __device__ __forceinline__ void done(const Unit&) const {}
};
struct BranchOrder {
    StaticOrder s;
    __device__ __forceinline__ bool next(int i, Unit& u) const { Unit t; if (i >= 3 || !s.tile((long)s.c, t)) return false; u.pm = i * 36 + t.pm; u.pn = i * 8 + t.pn; u.fl = 0; u.ko = 0; return true; }
    __device__ __forceinline__ void a_ready(const Unit&) const {}
    __device__ __forceinline__ void done(const Unit&) const {}
};
struct SingleOrder {
    int pm, pn;
    __device__ __forceinline__ bool next(int i, Unit& u) const { if (i != 0) return false; u.pm = pm; u.pn = pn; u.fl = 0; u.ko = 0; return true; }
    __device__ __forceinline__ void a_ready(const Unit&) const {}
    __device__ __forceinline__ void done(const Unit&) const {}
};
struct ExtraOrder {
    StaticOrder s;
    __device__ __forceinline__ bool next(int i, Unit& u) const { Unit t; if (i != 0 || s.c < 160) return false; const int e = s.c - 160, sp = e / 3, n = e - 3 * sp; if (!s.tile((long)(256 + sp), t)) return false;
        u.pm = n * 36 + t.pm; u.pn = n * 8 + t.pn; u.fl = 1 + sp; u.ko = 0; return true; }
    __device__ __forceinline__ void a_ready(const Unit&) const {}
    __device__ __forceinline__ void done(const Unit&) const {}
};

struct FirstRound {
    StaticOrder s;
    __device__ __forceinline__ bool next(int i, Unit& u) const { if (i != 0) return false; return s.tile((long)s.c, u); }
    __device__ __forceinline__ void a_ready(const Unit&) const {}
    __device__ __forceinline__ void done(const Unit&) const {}
};
struct PieceOrder {
    StaticOrder s;
    __device__ __forceinline__ bool next(int i, Unit& u) const { if (i != 0 || s.c < 128) return false; const int e = s.c - 128, sp = e >> 2, kq = e & 3; if (!s.tile((long)(256 + sp), u)) return false;
        u.fl = 1 + sp; u.ko = kq * 512; return true; }
    __device__ __forceinline__ void a_ready(const Unit&) const {}
    __device__ __forceinline__ void done(const Unit&) const {}
};
template <class Epi, class Sched>
__device__ __forceinline__ void gemm_phase(PG8_LAS unsigned char* lds, const Gemm g, const Sched& S, const Epi& E) {
    int tid = threadIdx.x; asm volatile("" : "+v"(tid));
    const int wid = __builtin_amdgcn_readfirstlane(tid >> 6), lane = tid & 63, wr = wid >> 2, wc = wid & 3, fr = lane & 15, fq = lane >> 4;
    const int K = g.ld, nt = g.K / BK;
    unsigned voffA[2], voffB[2];
#pragma unroll
    for (int i = 0; i < 2; ++i) { int R, C; stage_rc(tid * 16 + i * 8192, R, C); const int Rb = Epi::PERM ? ((R & ~31) + perm32(R & 31)) : R;
        voffA[i] = (unsigned)(R * K + C) * 2u; voffB[i] = (unsigned)(Rb * K + C) * 2u; }
    const size_t kstep = (size_t)(BK * 2);
    const size_t hstep = (size_t)HALF * K * 2;
    const size_t tstep = 2 * hstep;
    const unsigned ldsw = (unsigned)wid * 1024u;
    const int aoff = lds_byte(wr * 64 + fr, fq * 8), boff = lds_byte(wc * 32 + fr, fq * 8);
#define PG8_SA(b, h) (((b) * 2 + (h)) * HTB)
#define PG8_SB(b, h) ((4 + (b) * 2 + (h)) * HTB)
#define PG8_STAGE(bufoff, gbase, voff) do { _Pragma("unroll") for (int _i = 0; _i < 2; ++_i) \
        __builtin_amdgcn_global_load_lds((const unsigned*)((const char*)(gbase) + (voff)[_i]), (PG8_LAS unsigned*)(lds + (bufoff) + ldsw + _i * 8192), 16, 0, 0); } while (0)
#define PG8_LDA(dst, b, h) do { _Pragma("unroll") for (int m = 0; m < 4; ++m) _Pragma("unroll") for (int k = 0; k < 2; ++k) dst[m][k] = *(const PG8_LAS bf16x8*)(lds + PG8_SA(b, h) + aoff + m * 2048 + k * 1024); } while (0)
#define PG8_LDB(dst, b, h) do { _Pragma("unroll") for (int n = 0; n < 2; ++n) _Pragma("unroll") for (int k = 0; k < 2; ++k) dst[n][k] = *(const PG8_LAS bf16x8*)(lds + PG8_SB(b, h) + boff + n * 2048 + k * 1024); } while (0)
#define PG8_MMA(ai, bj, At, Bt) do { __builtin_amdgcn_s_setprio(1); _Pragma("unroll") for (int m = 0; m < 4; ++m) _Pragma("unroll") for (int n = 0; n < 2; ++n) _Pragma("unroll") for (int k = 0; k < 2; ++k) \
        acc[ai][bj][m][n] = __builtin_amdgcn_mfma_f32_16x16x32_bf16(Bt[n][k], At[m][k], acc[ai][bj][m][n], 0, 0, 0); __builtin_amdgcn_s_setprio(0); } while (0)
#define PG8_WAIT_V(n) asm volatile("s_waitcnt vmcnt(" #n ")" ::: "memory")
#define PG8_WAIT_L(n) asm volatile("s_waitcnt lgkmcnt(" #n ")" ::: "memory")
#define PG8_BAR __builtin_amdgcn_s_barrier()
#define PG8_SCHED __builtin_amdgcn_sched_barrier(0)
    Unit cur, nxt; int ui = 0;
    if (!S.next(0, cur)) return;
    f32x4 acc[2][2][4][2];
#pragma unroll
    for (int a = 0; a < 2; ++a)
#pragma unroll
        for (int b = 0; b < 2; ++b)
#pragma unroll
            for (int m = 0; m < 4; ++m)
#pragma unroll
                for (int n = 0; n < 2; ++n) acc[a][b][m][n] = (f32x4){0.f, 0.f, 0.f, 0.f};
    bf16x8 At[4][2], B0[2][2], B1[2][2];
    const char* cA = (const char*)g.A + (size_t)cur.pm * tstep + (size_t)cur.ko * 2; const char* cB = (const char*)g.Bt + (size_t)cur.pn * tstep + (size_t)cur.ko * 2;
    S.a_ready(cur);
    PG8_STAGE(PG8_SB(0, 0), cB, voffB); PG8_STAGE(PG8_SA(0, 0), cA, voffA); PG8_STAGE(PG8_SB(0, 1), cB + hstep, voffB); PG8_STAGE(PG8_SA(0, 1), cA + hstep, voffA);
    if (wr == 1) PG8_BAR;
    PG8_WAIT_V(4); PG8_BAR;
    PG8_STAGE(PG8_SB(1, 0), cB + kstep, voffB); PG8_STAGE(PG8_SA(1, 0), cA + kstep, voffA); PG8_STAGE(PG8_SB(1, 1), cB + hstep + kstep, voffB);
    PG8_WAIT_V(6); PG8_BAR;
    for (;;) {
        const bool has_next = S.next(ui + 1, nxt);
        const char* nA = has_next ? (const char*)g.A + (size_t)nxt.pm * tstep + (size_t)nxt.ko * 2 : cA; const char* nB = has_next ? (const char*)g.Bt + (size_t)nxt.pn * tstep + (size_t)nxt.ko * 2 : cB;
        for (int t = 0; t < nt; t += 2) {
            const bool last = (t == nt - 2);
            const char* a1 = cA + (size_t)(t + 1) * kstep;
            const char* a2 = last ? nA : cA + (size_t)(t + 2) * kstep; const char* b2 = last ? nB : cB + (size_t)(t + 2) * kstep;
            const char* a3 = a2 + kstep; const char* b3 = b2 + kstep;
            if (last && has_next) S.a_ready(nxt);
            PG8_LDB(B0, 0, 0); PG8_SCHED; PG8_LDA(At, 0, 0); PG8_STAGE(PG8_SA(1, 1), a1 + hstep, voffA);
            PG8_WAIT_L(8); PG8_BAR; PG8_WAIT_L(0); PG8_MMA(0, 0, At, B0); PG8_BAR; PG8_SCHED;
            PG8_LDB(B1, 0, 1); PG8_STAGE(PG8_SB(0, 0), b2, voffB);
            PG8_BAR; PG8_WAIT_L(0); PG8_MMA(0, 1, At, B1); PG8_BAR;
            PG8_LDA(At, 0, 1); PG8_STAGE(PG8_SA(0, 0), a2, voffA);
            PG8_BAR; PG8_WAIT_L(0); PG8_MMA(1, 0, At, B0); PG8_BAR; PG8_SCHED;
            PG8_STAGE(PG8_SB(0, 1), b2 + hstep, voffB);
            PG8_WAIT_V(6); PG8_BAR; PG8_MMA(1, 1, At, B1); PG8_BAR;
            PG8_LDB(B0, 1, 0); PG8_SCHED; PG8_LDA(At, 1, 0); PG8_STAGE(PG8_SA(0, 1), a2 + hstep, voffA);
            PG8_WAIT_L(8); PG8_BAR; PG8_WAIT_L(0); PG8_MMA(0, 0, At, B0); PG8_BAR; PG8_SCHED;
            PG8_LDB(B1, 1, 1); PG8_STAGE(PG8_SB(1, 0), b3, voffB);
            PG8_BAR; PG8_WAIT_L(0); PG8_MMA(0, 1, At, B1); PG8_BAR;
            PG8_LDA(At, 1, 1); PG8_STAGE(PG8_SA(1, 0), a3, voffA);
            PG8_BAR; PG8_WAIT_L(0); PG8_MMA(1, 0, At, B0); PG8_BAR; PG8_SCHED;
            PG8_STAGE(PG8_SB(1, 1), b3 + hstep, voffB);
            PG8_WAIT_V(6); PG8_BAR; PG8_MMA(1, 1, At, B1); PG8_BAR;
        }
        const bool clear_acc = E(acc, cur, wr, wc, fr, fq); S.done(cur);
        if (!has_next) break;
        if (clear_acc)
#pragma unroll
        for (int a = 0; a < 2; ++a)
#pragma unroll
            for (int b = 0; b < 2; ++b)
#pragma unroll
                for (int m = 0; m < 4; ++m)
#pragma unroll
                    for (int n = 0; n < 2; ++n) acc[a][b][m][n] = (f32x4){0.f, 0.f, 0.f, 0.f};
        cur = nxt; cA = nA; cB = nB; ++ui;
    }
    PG8_WAIT_V(0);
    if (wr == 0) PG8_BAR;
    PG8_BAR;
#undef PG8_SA
#undef PG8_SB
#undef PG8_STAGE
#undef PG8_LDA
#undef PG8_LDB
#undef PG8_MMA
#undef PG8_WAIT_V
#undef PG8_WAIT_L
#undef PG8_BAR
#undef PG8_SCHED
}
}

struct EpiZ {
    static constexpr bool PERM = true;
    bf16_t* Z; const float* ssx;
    __device__ __forceinline__ bool operator()(f32x4 (&acc)[2][2][4][2], const pg8::Unit& u, int wr, int wc, int fr, int fq) const {
        const int row0 = u.pm * 256 + wr * 64 + fr, col0 = u.pn * 256 + wc * 32 + 8 * fq;
        float ss[2][4];
#pragma unroll
        for (int ai = 0; ai < 2; ++ai)
#pragma unroll
            for (int m = 0; m < 4; ++m) ss[ai][m] = ssx[row0 + ai * 128 + m * 16];
#pragma unroll
        for (int ai = 0; ai < 2; ++ai)
#pragma unroll
            for (int m = 0; m < 4; ++m) { const int row = row0 + ai * 128 + m * 16; const float rs = rsqrtf(ss[ai][m] * (1.0f / 2048.0f) + EPS);
                bf16_t* rowp = Z + (size_t)row * NPAD + col0;
#pragma unroll
                for (int bj = 0; bj < 2; ++bj) { const f32x4 v0 = acc[ai][bj][m][0] * rs, v1 = acc[ai][bj][m][1] * rs;
                    u32x4 w; w.x = pk2(v0[0], v0[1]); w.y = pk2(v0[2], v0[3]); w.z = pk2(v1[0], v1[1]); w.w = pk2(v1[2], v1[3]);
                    *(u32x4*)(rowp + bj * 128) = w; } }
        return true;
    }
};
struct EpiBranch {
    static constexpr bool PERM = true;
    const bf16_t* Z; bf16_t* Mb;
    __device__ __forceinline__ bool operator()(f32x4 (&acc)[2][2][4][2], const pg8::Unit& u, int wr, int wc, int fr, int fq) const {
        const int n = u.pm / 36, pm = u.pm - 36 * n, pn = u.pn - 8 * n;
        const int row0 = pm * 256 + wr * 64 + fr, col0 = pn * 256 + wc * 32 + 8 * fq;
        const int nx = n < 2 ? 2048 : 0;
        u32x4 zg[2][2], zn[2][2];
#pragma unroll
        for (int bj = 0; bj < 2; ++bj) { const bf16_t* zp = Z + (size_t)row0 * NPAD + ZM + n * 2048 + col0 + bj * 128; zg[0][bj] = *(const u32x4*)zp; zn[0][bj] = *(const u32x4*)(zp + nx); }
#pragma unroll
        for (int gi = 0; gi < 8; ++gi) {
            if (gi < 7) { const int row = row0 + ((gi + 1) >> 2) * 128 + ((gi + 1) & 3) * 16;
#pragma unroll
                for (int bj = 0; bj < 2; ++bj) { const bf16_t* zp = Z + (size_t)row * NPAD + ZM + n * 2048 + col0 + bj * 128; zg[(gi + 1) & 1][bj] = *(const u32x4*)zp; zn[(gi + 1) & 1][bj] = *(const u32x4*)(zp + nx); } }
            __builtin_amdgcn_sched_barrier(0);
            const int ai = gi >> 2, m = gi & 3, row = row0 + ai * 128 + m * 16;
#pragma unroll
            for (int bj = 0; bj < 2; ++bj) { const int col = col0 + bj * 128;
                const u32x4 g = zg[gi & 1][bj], h = zn[gi & 1][bj];
                float f[8];
                const float zc[8] = {bflo(g.x), bfhi(g.x), bflo(g.y), bfhi(g.y), bflo(g.z), bfhi(g.z), bflo(g.w), bfhi(g.w)};
                const float zx[8] = {bflo(h.x), bfhi(h.x), bflo(h.y), bfhi(h.y), bflo(h.z), bfhi(h.z), bflo(h.w), bfhi(h.w)};
#pragma unroll
                for (int e = 0; e < 8; ++e) { const float ic = rcpf_(1.f + __expf(-zc[e])); f[e] = (n < 2) ? ic * (1.f + __expf(-zx[e])) : ic; }
                f32x4 v0 = acc[ai][bj][m][0], v1 = acc[ai][bj][m][1];
                v0[0] *= f[0]; v0[1] *= f[1]; v0[2] *= f[2]; v0[3] *= f[3]; v1[0] *= f[4]; v1[1] *= f[5]; v1[2] *= f[6]; v1[3] *= f[7];
                acc[ai][bj][m][0] = v0; acc[ai][bj][m][1] = v1;
                if (n == 2) { u32x4 w; w.x = pk2(v0[0], v0[1]); w.y = pk2(v0[2], v0[3]); w.z = pk2(v1[0], v1[1]); w.w = pk2(v1[2], v1[3]);
                    *(u32x4*)(Mb + (size_t)row * 2048 + col) = w; } }
            __builtin_amdgcn_sched_barrier(0);
        }
        return n == 2;
    }
};
struct EpiBranchAtomic {
    static constexpr bool PERM = true;
    const bf16_t* Z; bf16_t* SP;
    __device__ __forceinline__ bool operator()(f32x4 (&acc)[2][2][4][2], const pg8::Unit& u, int wr, int wc, int fr, int fq) const {
        const int n = u.pm / 36, pm = u.pm - 36 * n, pn = u.pn - 8 * n;
        const int rl0 = wr * 64 + fr, cl0 = wc * 32 + 8 * fq;
        bf16_t* sp = SP + (size_t)(n * 32 + u.fl - 1) * 65536;
        const bf16_t* zb = Z + (size_t)(pm * 256 + rl0) * NPAD + ZM + n * 2048 + pn * 256 + cl0;
        u32x4 zg[2][2];
#pragma unroll
        for (int bj = 0; bj < 2; ++bj) zg[0][bj] = *(const u32x4*)(zb + bj * 128);
#pragma unroll
        for (int gi = 0; gi < 8; ++gi) {
            if (gi < 7) {
#pragma unroll
                for (int bj = 0; bj < 2; ++bj) zg[(gi + 1) & 1][bj] = *(const u32x4*)(zb + (size_t)(((gi + 1) >> 2) * 128 + ((gi + 1) & 3) * 16) * NPAD + bj * 128); }
            __builtin_amdgcn_sched_barrier(0);
            const int ai = gi >> 2, m = gi & 3;
#pragma unroll
            for (int bj = 0; bj < 2; ++bj) { const int rl = rl0 + ai * 128 + m * 16, cl = cl0 + bj * 128; const u32x4 g = zg[gi & 1][bj];
                const f32x4 v0 = acc[ai][bj][m][0], v1 = acc[ai][bj][m][1];
                u32x4 w; w.x = pk2(v0[0] * sigm(bflo(g.x)), v0[1] * sigm(bfhi(g.x))); w.y = pk2(v0[2] * sigm(bflo(g.y)), v0[3] * sigm(bfhi(g.y)));
                w.z = pk2(v1[0] * sigm(bflo(g.z)), v1[1] * sigm(bfhi(g.z))); w.w = pk2(v1[2] * sigm(bflo(g.w)), v1[3] * sigm(bfhi(g.w)));
                *(u32x4*)(sp + rl * 256 + cl) = w; }
            __builtin_amdgcn_sched_barrier(0);
        }
        return true;
    }
};
struct EpiPart {
    static constexpr bool PERM = true;
    float* PT;
    __device__ __forceinline__ bool operator()(f32x4 (&acc)[2][2][4][2], const pg8::Unit& u, int wr, int wc, int fr, int fq) const {
        const int rl0 = wr * 64 + fr, cl0 = wc * 32 + 8 * fq;
        float* pt = PT + (size_t)((u.ko >> 9) * 32 + u.fl - 1) * 65536;
#pragma unroll
        for (int ai = 0; ai < 2; ++ai)
#pragma unroll
            for (int m = 0; m < 4; ++m)
#pragma unroll
                for (int bj = 0; bj < 2; ++bj) { float* o = pt + (rl0 + ai * 128 + m * 16) * 256 + cl0 + bj * 128; *(f32x4*)o = acc[ai][bj][m][0]; *(f32x4*)(o + 4) = acc[ai][bj][m][1]; }
        return true;
    }
};
struct EpiSS {
    static constexpr bool PERM = true;
    bf16_t* O; float* ss;
    __device__ __forceinline__ bool operator()(f32x4 (&acc)[2][2][4][2], const pg8::Unit& u, int wr, int wc, int fr, int fq) const {
        const int row0 = u.pm * 256 + wr * 64 + fr, col0 = u.pn * 256 + wc * 32 + 8 * fq;
#pragma unroll
        for (int ai = 0; ai < 2; ++ai)
#pragma unroll
            for (int m = 0; m < 4; ++m) { const int row = row0 + ai * 128 + m * 16; float s = 0.f;
#pragma unroll
                for (int bj = 0; bj < 2; ++bj) { const f32x4 v0 = acc[ai][bj][m][0], v1 = acc[ai][bj][m][1];
                    s += (v0[0] * v0[0] + v0[1] * v0[1]) + (v0[2] * v0[2] + v0[3] * v0[3]) + (v1[0] * v1[0] + v1[1] * v1[1]) + (v1[2] * v1[2] + v1[3] * v1[3]);
                    u32x4 w; w.x = pk2(v0[0], v0[1]); w.y = pk2(v0[2], v0[3]); w.z = pk2(v1[0], v1[1]); w.w = pk2(v1[2], v1[3]);
                    *(u32x4*)(O + (size_t)row * 2048 + col0 + bj * 128) = w; }
                s += __shfl_xor(s, 16); s += __shfl_xor(s, 32);
                if (fq == 0) atomicAdd(ss + row, s); }
        return true;
    }
};
struct EpiGate {
    static constexpr bool PERM = true;
    const bf16_t* XN; const bf16_t* ER; const float* sse; const float* pnorm; float* XO; bf16_t* XB; float* ssx;
    __device__ __forceinline__ bool operator()(f32x4 (&acc)[2][2][4][2], const pg8::Unit& u, int wr, int wc, int fr, int fq) const {
        const int row0 = u.pm * 256 + wr * 64 + fr, col0 = u.pn * 256 + wc * 32 + 8 * fq;
        f32x4 pn[2][2];
#pragma unroll
        for (int bj = 0; bj < 2; ++bj) { pn[bj][0] = *(const f32x4*)(pnorm + col0 + bj * 128); pn[bj][1] = *(const f32x4*)(pnorm + col0 + bj * 128 + 4); }
        u32x4 xv[2][2], ev[2][2]; float rsv[2];
        rsv[0] = sse[row0];
#pragma unroll
        for (int bj = 0; bj < 2; ++bj) { const size_t off = (size_t)row0 * 2048 + col0 + bj * 128; xv[0][bj] = *(const u32x4*)(XN + off); ev[0][bj] = *(const u32x4*)(ER + off); }
#pragma unroll
        for (int g = 0; g < 8; ++g) {
            if (g < 7) { const int row = row0 + ((g + 1) >> 2) * 128 + ((g + 1) & 3) * 16; rsv[(g + 1) & 1] = sse[row];
#pragma unroll
                for (int bj = 0; bj < 2; ++bj) { const size_t off = (size_t)row * 2048 + col0 + bj * 128; xv[(g + 1) & 1][bj] = *(const u32x4*)(XN + off); ev[(g + 1) & 1][bj] = *(const u32x4*)(ER + off); } }
            __builtin_amdgcn_sched_barrier(0);
            {
                const int ai = g >> 2, m = g & 3;
                const int row = row0 + ai * 128 + m * 16;
                float s = 0.f; const float rs = rsqrtf(rsv[g & 1] * (1.0f / 2048.0f) + EPS);
#pragma unroll
                for (int bj = 0; bj < 2; ++bj) { const size_t off = (size_t)row * 2048 + col0 + bj * 128;
                    const f32x4 p0 = pn[bj][0], p1 = pn[bj][1];
                    const u32x4 e = ev[g & 1][bj], x = xv[g & 1][bj]; const f32x4 a0 = acc[ai][bj][m][0], a1 = acc[ai][bj][m][1];
                    f32x4 o0, o1;
                    o0[0] = bflo(x.x) + bflo(e.x) * rs * p0[0] * sigm(a0[0]); o0[1] = bfhi(x.x) + bfhi(e.x) * rs * p0[1] * sigm(a0[1]);
                    o0[2] = bflo(x.y) + bflo(e.y) * rs * p0[2] * sigm(a0[2]); o0[3] = bfhi(x.y) + bfhi(e.y) * rs * p0[3] * sigm(a0[3]);
                    o1[0] = bflo(x.z) + bflo(e.z) * rs * p1[0] * sigm(a1[0]); o1[1] = bfhi(x.z) + bfhi(e.z) * rs * p1[1] * sigm(a1[1]);
                    o1[2] = bflo(x.w) + bflo(e.w) * rs * p1[2] * sigm(a1[2]); o1[3] = bfhi(x.w) + bfhi(e.w) * rs * p1[3] * sigm(a1[3]);
                    if (XO) { *(f32x4*)(XO + off) = o0; *(f32x4*)(XO + off + 4) = o1; }
                    if (XB) { u32x4 w; w.x = pk2(o0[0], o0[1]); w.y = pk2(o0[2], o0[3]); w.z = pk2(o1[0], o1[1]); w.w = pk2(o1[2], o1[3]); *(u32x4*)(XB + off) = w;
                        s += (o0[0] * o0[0] + o0[1] * o0[1]) + (o0[2] * o0[2] + o0[3] * o0[3]) + (o1[0] * o1[0] + o1[1] * o1[1]) + (o1[2] * o1[2] + o1[3] * o1[3]); } }
                if (XB) { s += __shfl_xor(s, 16); s += __shfl_xor(s, 32); if (fq == 0) atomicAdd(ssx + row, s); }
            }
            __builtin_amdgcn_sched_barrier(0);
        }
        return true;
    }
};

struct Params { const float* in[31]; float* out; unsigned char* ws; };
struct Ctx {
    float* out; unsigned char* ws;
    LAS unsigned char* lds; int tid, lane, wave, G, bid;
    unsigned* ctl;
};
#define WSP(T, off) ((T*)(C.ws + (off)))
#define WSPL(T, off) ((T*)(CL.ws + (off)))

__device__ __forceinline__ int win_src(int n0) {
    if (n0 < 4096) return n0;
    if (n0 < 6144) return n0 + 96;
    if (n0 < 6240) return n0 - 2048;
    if (n0 < 6336) return n0;
    if (n0 < 6400) return -1;
    return n0 - 64;
}
__device__ __forceinline__ void tr_item(const float* W, int ldw, int srccol0, const float* gk, int k0, bf16_t* WT, int K, int n0, LAS float* scr, int lane) {
    const int r8 = lane >> 3, c4 = (lane & 7) * 4;
    f32x4 v[8]; float gs[8];
    const int sc0 = srccol0 >= 0 ? srccol0 : 0; const float zs = srccol0 >= 0 ? 1.f : 0.f; const float* gp = gk ? gk : W;
#pragma unroll
    for (int i = 0; i < 8; ++i) { v[i] = *(const f32x4*)(W + (size_t)(k0 + 8 * i + r8) * ldw + sc0 + c4); const float gv = gp[k0 + 8 * i + r8]; gs[i] = gk ? gv * zs : zs; }
#pragma unroll
    for (int i = 0; i < 8; ++i) { LAS float* d = scr + (8 * i + r8) * 33 + c4; d[0] = v[i][0] * gs[i]; d[1] = v[i][1] * gs[i]; d[2] = v[i][2] * gs[i]; d[3] = v[i][3] * gs[i]; }
    LDS_WAIT();
    const int c = lane & 7;
#pragma unroll
    for (int j = 0; j < 4; ++j) { const int n = (lane >> 3) + 8 * j; const LAS float* s = scr + (8 * c) * 33 + n;
        u32x4 o; o.x = pk2(s[0 * 33], s[1 * 33]); o.y = pk2(s[2 * 33], s[3 * 33]); o.z = pk2(s[4 * 33], s[5 * 33]); o.w = pk2(s[6 * 33], s[7 * 33]);
        *(u32x4*)(WT + (size_t)(n0 + n) * K + k0 + 8 * c) = o; }
    LDS_WAIT();
}
constexpr int CONV_ITEMS = 26112, CONV_SPLIT = 11000;
__device__ __forceinline__ void conv_layer_items(const Params& P, const Ctx& C, int l, int lo, int hi, int gwf, int ngwf) {
    int lane = C.lane; asm volatile("" : "+v"(lane));
    LAS float* scr = (LAS float*)(C.lds + C.wave * 8448);
    for (int it = lo + gwf; it < hi; it += ngwf) {
        int r = it;
        if (r < 18688) { const int kb = r / 584, nb = r - kb * 584;
            tr_item(P.in[9] + (size_t)l * 2048 * DIN, DIN, win_src(32 * nb), P.in[8] + l * 2048, 64 * kb, WSP(bf16_t, WS_WIN) + (size_t)l * NPAD * 2048, 2048, 32 * nb, scr, lane); continue; }
        r -= 18688;
        if (r < 3072) { const int n = r / 1024; r -= n * 1024; const int ln = l * 3 + n, kb = r / 64, nb = r - kb * 64;
            tr_item(P.in[25] + (size_t)ln * 1024 * 2048, 2048, 32 * nb, nullptr, 64 * kb, WSP(bf16_t, WS_WBR) + (size_t)ln * 2048 * 1024, 1024, 32 * nb, scr, lane); continue; }
        r -= 3072;
        if (r < 2048) { const int kb = r / 64, nb = r - kb * 64;
            tr_item(P.in[26] + (size_t)l * 2048 * 2048, 2048, 32 * nb, nullptr, 64 * kb, WSP(bf16_t, WS_WOUT) + (size_t)l * 2048 * 2048, 2048, 32 * nb, scr, lane); continue; }
        r -= 2048;
        if (r < 2048) { const int kb = r / 64, nb = r - kb * 64;
            tr_item(P.in[30] + (size_t)l * 2048 * 2048, 2048, 32 * nb, nullptr, 64 * kb, WSP(bf16_t, WS_WGATE) + (size_t)l * 2048 * 2048, 2048, 32 * nb, scr, lane); continue; }
        r -= 2048;
        { const int kb = r / 64, nb = r - kb * 64;
            tr_item(P.in[28] + (size_t)l * 256 * 2048, 2048, 32 * nb, nullptr, 64 * kb, WSP(bf16_t, WS_WUP) + (size_t)l * 2048 * 256, 256, 32 * nb, scr, lane); }
    }
}
__device__ __forceinline__ void phase0(const Params& P, const Ctx& C) {
    LAS float* scr = (LAS float*)(C.lds + C.wave * 8448);
    const int gw = C.bid * 8 + C.wave, NGW = C.G * 8, lane = C.lane;
    conv_layer_items(P, C, 0, 0, 18688, gw, NGW);
    conv_layer_items(P, C, 0, 18688, 21760, gw, NGW);
    conv_layer_items(P, C, 0, 25856, CONV_ITEMS, gw, NGW);
    for (int it = gw; it < 64; it += NGW) {
        if (it < 32) { const int kb = it / 2, nb = it - kb * 2;
            tr_item(P.in[20], 64, 32 * nb, nullptr, 64 * kb, WSP(bf16_t, WS_V1T), 1024, 32 * nb, scr, lane); }
        else { const int nb = it - 32;
            tr_item(P.in[21], 1024, 32 * nb, nullptr, 0, WSP(bf16_t, WS_V2T), 64, 32 * nb, scr, lane); }
    }
    for (int m = gw; m < M; m += NGW) {
        const float* xr = (m < MP) ? P.in[0] + (size_t)m * 2048 : P.in[1] + (size_t)(m - MP) * 2048;
        bf16_t* o = WSP(bf16_t, WS_XB) + (size_t)m * 2048; float s = 0.f; f32x4 xv[8];
#pragma unroll
        for (int j = 0; j < 8; ++j) xv[j] = *(const f32x4*)(xr + 4 * lane + 256 * j);
        __builtin_amdgcn_sched_barrier(0);
#pragma unroll
        for (int j = 0; j < 8; ++j) { const f32x4 v = xv[j]; s += (v[0] * v[0] + v[1] * v[1]) + (v[2] * v[2] + v[3] * v[3]);
            u32x2 w; w.x = pk2(v[0], v[1]); w.y = pk2(v[2], v[3]); *(u32x2*)(o + 4 * lane + 256 * j) = w; }
        s = wave_sum(s);
        if (lane == 0) WSP(float, WS_SS)[m] = s;
    }
    for (int r = gw; r < 2 * M; r += NGW) { const int l = r / M, m = r - l * M;
        const float* pr = (m < MP) ? P.in[6] + ((size_t)l * MP + m) * 256 : P.in[7] + ((size_t)l * 1024 + (m - MP)) * 256;
        const f32x4 v = *(const f32x4*)(pr + 4 * lane); u32x2 w; w.x = pk2(v[0], v[1]); w.y = pk2(v[2], v[3]);
        *(u32x2*)(WSP(bf16_t, WS_PB) + (size_t)r * 256 + 4 * lane) = w; }
    const int gt = C.bid * NTHREADS + C.tid, NGT = C.G * NTHREADS;
    for (int i = gt; i < 5 * M; i += NGT) WSP(float, WS_SS)[M + i] = 0.f;
    for (int i = gt; i < 2 * 1024 * 96; i += NGT) { const int l = i / (1024 * 96), r = i - l * 1024 * 96, n = r / 96, k = r - n * 96;
        WSP(bf16_t, WS_W2T)[i] = (bf16_t)(pk2(P.in[14][(size_t)l * 96 * 1024 + k * 1024 + n], 0.f) & 0xffff);
        WSP(bf16_t, WS_A2T)[i] = (bf16_t)(pk2(P.in[16][(size_t)l * 96 * 1024 + k * 1024 + n], 0.f) & 0xffff); }
    for (int i = gt; i < 2056 * 128; i += NGT) { const int pi = i >> 7, ii = i & 127; const int pos = pi < 2048 ? pi : 16384 + (pi - 2048);
        const float inv = exp2f(-(float)ii * (13.287712379549449f / 128.0f)); const float ang = (float)pos * inv;
        const double a = (double)ang; const double k = rint(a * 0.15915494309189535); const float rr = (float)(a - k * 6.283185307179586);
        f32x2 cs; cs.x = __cosf(rr); cs.y = __sinf(rr); WSP(f32x2, WS_ROPE)[i] = cs; }
}

__device__ __forceinline__ bool seq_first(int g) { return g < MP ? ((g & 2047) == 0) : (((g - MP) & 7) == 0); }
__device__ __forceinline__ void unpack8(const u32x4 q, float (&o)[8]) { o[0] = bflo(q.x); o[1] = bfhi(q.x); o[2] = bflo(q.y); o[3] = bfhi(q.y); o[4] = bflo(q.z); o[5] = bfhi(q.z); o[6] = bflo(q.w); o[7] = bfhi(q.w); }
__device__ __forceinline__ void mix8(const bf16_t* Z, int g, int zc, int oc, bool first, const float* srow, const float* mu, float (&o)[8]) {
    float cur[8], prv[8], sv[8];
    unpack8(*(const u32x4*)(Z + (size_t)g * NPAD + zc), cur);
    unpack8(*(const u32x4*)(Z + (size_t)(first ? g : g - 1) * NPAD + zc), prv);
    { const float* sp = srow ? srow : mu; const float sc = srow ? 1.f : 0.f; const f32x4 a = *(const f32x4*)(sp + oc) * sc, b = *(const f32x4*)(sp + oc + 4) * sc;
      sv[0] = a[0]; sv[1] = a[1]; sv[2] = a[2]; sv[3] = a[3]; sv[4] = b[0]; sv[5] = b[1]; sv[6] = b[2]; sv[7] = b[3]; }
    const f32x4 m0 = *(const f32x4*)(mu + oc), m1 = *(const f32x4*)(mu + oc + 4);
    const float mm[8] = {m0[0], m0[1], m0[2], m0[3], m1[0], m1[1], m1[2], m1[3]};
#pragma unroll
    for (int j = 0; j < 8; ++j) { const float pv = first ? sv[j] : prv[j]; o[j] = cur[j] + (pv - cur[j]) * mm[j]; }
}
struct Mix8Raw { u32x4 cur, prv; f32x4 sa, sb, m0, m1; };
template <bool SMP>
__device__ __forceinline__ Mix8Raw mix8_load(const bf16_t* Z, int g, int zc, int oc, bool first, const float* srow, const float* mu) {
    Mix8Raw r;
    r.cur = *(const u32x4*)(Z + (size_t)g * NPAD + zc); r.prv = *(const u32x4*)(Z + (size_t)(first ? g : g - 1) * NPAD + zc);
    if (SMP) { r.sa = *(const f32x4*)(srow + oc); r.sb = *(const f32x4*)(srow + oc + 4); } else { r.sa = (f32x4){0.f, 0.f, 0.f, 0.f}; r.sb = r.sa; }
    r.m0 = *(const f32x4*)(mu + oc); r.m1 = *(const f32x4*)(mu + oc + 4);
    return r;
}
__device__ __forceinline__ void mix8_calc(const Mix8Raw& r, bool first, bool has_srow, float (&o)[8]) {
    float cur[8], prv[8]; unpack8(r.cur, cur); unpack8(r.prv, prv);
    const float sc = has_srow ? 1.f : 0.f; const f32x4 a = r.sa * sc, b = r.sb * sc;
    const float sv[8] = {a[0], a[1], a[2], a[3], b[0], b[1], b[2], b[3]};
    const float mm[8] = {r.m0[0], r.m0[1], r.m0[2], r.m0[3], r.m1[0], r.m1[1], r.m1[2], r.m1[3]};
#pragma unroll
    for (int j = 0; j < 8; ++j) { const float pv = first ? sv[j] : prv[j]; o[j] = cur[j] + (pv - cur[j]) * mm[j]; }
}
__device__ __forceinline__ bf16x8 pack8(const float (&u)[8]) {
    u32x4 w; w.x = pk2(u[0], u[1]); w.y = pk2(u[2], u[3]); w.z = pk2(u[4], u[5]); w.w = pk2(u[6], u[7]);
    return __builtin_bit_cast(bf16x8, w);
}
__device__ __forceinline__ void unpack4(const u32x2 q, float (&o)[4]) { o[0] = bflo(q.x); o[1] = bfhi(q.x); o[2] = bflo(q.y); o[3] = bfhi(q.y); }
__device__ __forceinline__ u32x2 pack4(float a, float b, float c, float d) { u32x2 w; w.x = pk2(a, b); w.y = pk2(c, d); return w; }

template <int l, bool SMP>
__device__ __forceinline__ void p2a_item(const Params& P, const Ctx& C, int item) {
    int tid = C.tid; asm volatile("" : "+v"(tid)); const int lane = tid & 63, w = C.wave, c = lane & 15, tg = lane >> 4;
    const int g0 = item * 16;
    const bf16_t* Z = WSP(bf16_t, WS_Z);
    const float* mu = P.in[12] + (size_t)l * 3264;
    { const char* zb = (const char*)Z + (size_t)ZR * 2;
#pragma unroll
      for (int q = 0; q < 2; ++q) { const int i = tid + 512 * q, row = i / 51, ln = i - row * 51; int g = g0 - 1 + row; g = g < 0 ? 0 : g;
          if (i < 17 * 51) (void)*(const volatile unsigned*)(zb + (size_t)g * (NPAD * 2) + ln * 128); }
      if (l == 1) { const int row = tid >> 5, ln = tid & 31; (void)*(const volatile unsigned*)((const char*)WSP(bf16_t, WS_VB) + (size_t)(g0 + (row & 15)) * 2048 + (ln & 15) * 128); } }
    bf16x8 Aw[3], Aa[3], At[2];
    {
        const int g = g0 + c; const bool first = seq_first(g);
        const float* srow = (g < MP) ? nullptr : P.in[4] + ((size_t)l * 128 + ((g - MP) >> 3)) * 3264;
        { Mix8Raw rw[3], ra[3];
#pragma unroll
          for (int ks = 0; ks < 3; ++ks) { rw[ks] = mix8_load<SMP>(Z, g, ZWL + 32 * ks + 8 * tg, 1024 + 32 * ks + 8 * tg, first, srow, mu); ra[ks] = mix8_load<SMP>(Z, g, ZAL + 32 * ks + 8 * tg, 3168 + 32 * ks + 8 * tg, first, srow, mu); }
          __builtin_amdgcn_sched_barrier(0);
#pragma unroll
          for (int ks = 0; ks < 3; ++ks) { float u[8];
            mix8_calc(rw[ks], first, SMP, u);
#pragma unroll
            for (int j = 0; j < 8; ++j) { const float e = __expf(2.f * u[j]); u[j] = 1.f - 2.f * rcpf_(e + 1.f); }
            Aw[ks] = pack8(u);
            mix8_calc(ra[ks], first, SMP, u);
            Aa[ks] = pack8(u); } }
        if (l == 1) {
            f32x4 pv[4];
#pragma unroll
            for (int nt = 0; nt < 4; ++nt) pv[nt] = (f32x4){0.f, 0.f, 0.f, 0.f};
            const bf16_t* V1T = WSP(bf16_t, WS_V1T);
#pragma unroll
            for (int kp = 0; kp < 2; ++kp) { bf16x8 va[2], vbf[2][4]; Mix8Raw rv[2];
#pragma unroll
                for (int k2 = 0; k2 < 2; ++k2) { const int kc = 128 * w + 32 * (2 * kp + k2) + 8 * tg;
                    rv[k2] = mix8_load<SMP>(Z, g, ZV + kc, 2144 + kc, first, srow, mu);
#pragma unroll
                    for (int nt = 0; nt < 4; ++nt) vbf[k2][nt] = *(const bf16x8*)(V1T + (size_t)(16 * nt + c) * 1024 + kc); }
                __builtin_amdgcn_sched_barrier(0);
#pragma unroll
                for (int k2 = 0; k2 < 2; ++k2) { float u[8]; mix8_calc(rv[k2], first, SMP, u); va[k2] = pack8(u); }
#pragma unroll
                for (int k2 = 0; k2 < 2; ++k2)
#pragma unroll
                    for (int nt = 0; nt < 4; ++nt) pv[nt] = MFMA16(va[k2], vbf[k2][nt], pv[nt]); }
            LAS float* part = (LAS float*)C.lds;
#pragma unroll
            for (int nt = 0; nt < 4; ++nt)
#pragma unroll
                for (int i = 0; i < 4; ++i) part[(w * 16 + 4 * tg + i) * 64 + 16 * nt + c] = pv[nt][i];
            __syncthreads();
            { const int tok = tid >> 5, n2 = (tid & 31) * 2; float s0 = 0.f, s1 = 0.f;
#pragma unroll
                for (int ww = 0; ww < 8; ++ww) { const f32x2 v = *(const LAS f32x2*)(part + (ww * 16 + tok) * 64 + n2); s0 += v.x; s1 += v.y; }
                *(LAS unsigned*)(C.lds + 32768 + (tok * 64 + n2) * 2) = pk2(s0, s1); }
            __syncthreads();
#pragma unroll
            for (int ks = 0; ks < 2; ++ks) At[ks] = *(const LAS bf16x8*)(C.lds + 32768 + (c * 64 + 32 * ks + 8 * tg) * 2);
        }
    }
    const bf16_t* W2T = WSP(bf16_t, WS_W2T) + (size_t)l * 1024 * 96;
    const bf16_t* A2T = WSP(bf16_t, WS_A2T) + (size_t)l * 1024 * 96;
    const bf16_t* V2T = WSP(bf16_t, WS_V2T);
    const int gt = g0 + 4 * tg; const bool f4 = seq_first(gt);
    const float* srow4 = (gt < MP) ? nullptr : P.in[4] + ((size_t)l * 128 + ((gt - MP) >> 3)) * 3264;
#pragma unroll 1
    for (int hh = 0; hh < 2; ++hh) {
        const int hd = 2 * w + hh, ch0 = 64 * hd + 4 * c;
        f32x4 aw[4], aa[4], vl[4];
        {
            bf16x8 bw[4][3], ba[4][3], bv[4][2];
#pragma unroll
            for (int q = 0; q < 4; ++q) {
#pragma unroll
                for (int ks = 0; ks < 3; ++ks) { bw[q][ks] = *(const bf16x8*)(W2T + (size_t)(ch0 + q) * 96 + 32 * ks + 8 * tg); ba[q][ks] = *(const bf16x8*)(A2T + (size_t)(ch0 + q) * 96 + 32 * ks + 8 * tg); }
                if (l == 1) {
#pragma unroll
                    for (int ks = 0; ks < 2; ++ks) bv[q][ks] = *(const bf16x8*)(V2T + (size_t)(ch0 + q) * 64 + 32 * ks + 8 * tg); } }
            __builtin_amdgcn_sched_barrier(0);
#pragma unroll
            for (int q = 0; q < 4; ++q) { aw[q] = (f32x4){0.f, 0.f, 0.f, 0.f}; aa[q] = aw[q]; vl[q] = aw[q];
#pragma unroll
                for (int ks = 0; ks < 3; ++ks) { aw[q] = MFMA16(Aw[ks], bw[q][ks], aw[q]); aa[q] = MFMA16(Aa[ks], ba[q][ks], aa[q]); }
                if (l == 1) {
#pragma unroll
                    for (int ks = 0; ks < 2; ++ks) vl[q] = MFMA16(At[ks], bv[q][ks], vl[q]); } }
        }
        const f32x4 mur = *(const f32x4*)(mu + ch0), muk = *(const f32x4*)(mu + 1120 + ch0), muv = *(const f32x4*)(mu + 2144 + ch0);
        const f32x4 w0 = *(const f32x4*)(P.in[13] + l * 1024 + ch0), a0 = *(const f32x4*)(P.in[15] + l * 1024 + ch0);
        const f32x4 kkc = *(const f32x4*)(P.in[17] + l * 1024 + ch0), kac = *(const f32x4*)(P.in[18] + l * 1024 + ch0), rkc = *(const f32x4*)(P.in[22] + l * 1024 + ch0);
        f32x4 v0c = (f32x4){0.f, 0.f, 0.f, 0.f}; if (l == 1) v0c = *(const f32x4*)(P.in[19] + ch0);
        float pr[4], pk[4], pvv[4];
        { const bf16_t* zp = Z + (size_t)(f4 ? gt : gt - 1) * NPAD + ch0; float zr_[4], zk_[4], zv_[4];
          unpack4(*(const u32x2*)(zp + ZR), zr_); unpack4(*(const u32x2*)(zp + ZK), zk_); unpack4(*(const u32x2*)(zp + ZV), zv_);
          f32x4 sa = (f32x4){0.f, 0.f, 0.f, 0.f}, sb = sa, sd = sa;
          if (SMP) { sa = *(const f32x4*)(srow4 + ch0); sb = *(const f32x4*)(srow4 + 1120 + ch0); sd = *(const f32x4*)(srow4 + 2144 + ch0); }
#pragma unroll
          for (int q = 0; q < 4; ++q) { pr[q] = f4 ? sa[q] : zr_[q]; pk[q] = f4 ? sb[q] : zk_[q]; pvv[q] = f4 ? sd[q] : zv_[q]; } }
        u32x2 zrw[4], zkw[4], zvw[4], vfw[4];
        constexpr int NPRE = (l == 0) ? 4 : 2;
#pragma unroll
        for (int i = 0; i < 4; ++i) {
            if (i % NPRE == 0) {
#pragma unroll
                for (int ii = i; ii < i + NPRE; ++ii) { const bf16_t* zrow = Z + (size_t)(gt + ii) * NPAD + ch0; zrw[ii] = *(const u32x2*)(zrow + ZR); zkw[ii] = *(const u32x2*)(zrow + ZK); zvw[ii] = *(const u32x2*)(zrow + ZV);
                    vfw[ii] = (u32x2){0u, 0u}; if (l == 1) vfw[ii] = *(const u32x2*)(WSP(bf16_t, WS_VB) + (size_t)(gt + ii) * 1024 + ch0); } }
            const int g = gt + i; const size_t eo = (size_t)g * 1024 + ch0;
            float cr[4], ck[4], cv[4], vf[4];
            unpack4(zrw[i], cr); unpack4(zkw[i], ck); unpack4(zvw[i], cv);
            if (l == 1) unpack4(vfw[i], vf);
            float r[4], k[4], v[4], a[4], kkr[4], kp[4]; f32x4 dw; float ss = 0.f, bon = 0.f;
#pragma unroll
            for (int q = 0; q < 4; ++q) {
                r[q] = cr[q] + (pr[q] - cr[q]) * mur[q]; k[q] = ck[q] + (pk[q] - ck[q]) * muk[q]; v[q] = cv[q] + (pvv[q] - cv[q]) * muv[q];
                pr[q] = cr[q]; pk[q] = ck[q]; pvv[q] = cv[q];
                const float wl = w0[q] + aw[q][i]; dw[q] = __expf(-0.6065306597126334f * sigm(wl));
                a[q] = sigm(a0[q] + aa[q][i]);
                kkr[q] = k[q] * kkc[q]; ss += kkr[q] * kkr[q];
                kp[q] = k[q] * (1.f + (a[q] - 1.f) * kac[q]);
                if (l == 1) v[q] = v[q] + (vf[q] - v[q]) * sigm(v0c[q] + vl[q][i]);
                bon += r[q] * kp[q] * rkc[q];
            }
            ss = red16(ss); bon = red16(bon);
            const float inv = __builtin_amdgcn_rsqf(fmaxf(ss, 1e-24f));
            float kk[4];
#pragma unroll
            for (int q = 0; q < 4; ++q) kk[q] = kkr[q] * inv;
            *(f32x4*)(WSP(float, WS_DW) + eo) = dw;
            *(u32x2*)(WSP(bf16_t, WS_R) + eo) = pack4(r[0], r[1], r[2], r[3]);
            *(u32x2*)(WSP(bf16_t, WS_KK) + eo) = pack4(kk[0], kk[1], kk[2], kk[3]);
            *(u32x2*)(WSP(bf16_t, WS_BB) + eo) = pack4(kk[0] * a[0], kk[1] * a[1], kk[2] * a[2], kk[3] * a[3]);
            *(u32x2*)(WSP(bf16_t, WS_KP) + eo) = pack4(kp[0], kp[1], kp[2], kp[3]);
            *(u32x2*)(WSP(bf16_t, WS_VB) + (size_t)l * M * 1024 + eo) = pack4(v[0], v[1], v[2], v[3]);
            if (c == 0) WSP(float, WS_BONUS)[(size_t)g * 16 + hd] = bon;
        }
    }
    {
        const bool prompt = g0 < MP;
        const int nlast = prompt ? (((g0 + 16) & 2047) == 0 ? 1 : 0) : 2;
        for (int q = 0; q < nlast; ++q) {
            const int g = prompt ? g0 + 15 : g0 + 7 + 8 * q;
            float* o = prompt ? C.out + OFF_SHP + ((size_t)l * 4 + (g >> 11)) * 3264 : C.out + OFF_SHS + ((size_t)l * 128 + ((g - MP) >> 3)) * 3264;
            for (int oc = tid; oc < 3264; oc += NTHREADS) {
                const int zc = oc < 1024 ? ZR + oc : oc < 1120 ? ZWL + (oc - 1024) : oc < 2144 ? ZK + (oc - 1120) : oc < 3168 ? ZV + (oc - 2144) : ZAL + (oc - 3168);
                o[oc] = bf2f(Z[(size_t)g * NPAD + zc]); }
        }
    }
    if (l == 1) __syncthreads();
}

struct SeqInfo { int base, T, b; bool prompt; };
__device__ __forceinline__ SeqInfo seq_info(int sq) { SeqInfo s; s.prompt = sq < 4; s.b = s.prompt ? sq : sq - 4; s.base = s.prompt ? sq * 2048 : MP + (sq - 4) * 8; s.T = s.prompt ? 2048 : 8; return s; }

constexpr int RO_AT = 0, RO_RH = 2304, RO_BK = 4608, RO_M1 = 8704, RO_BKR = 9728, RO_VT = 10752, RO_GC = 12800;
__device__ __forceinline__ f32x4 mm16f(const LAS float* A, const LAS float* B, f32x4 acc, int fr, int fq) {
#pragma unroll
    for (int kk = 0; kk < 4; ++kk) acc = __builtin_amdgcn_mfma_f32_16x16x4f32(A[fr * 16 + 4 * kk + fq], B[(4 * kk + fq) * 16 + fr], acc, 0, 0, 0);
    return acc;
}
__device__ __forceinline__ void st16f(LAS float* D, const f32x4 acc, int fr, int fq) {
#pragma unroll
    for (int r = 0; r < 4; ++r) D[(4 * fq + r) * 16 + fr] = acc[r];
}
__device__ __forceinline__ void rwkv_prep_item(const Params& P, const Ctx& C, int l, int item, LAS unsigned char* wl, int lane) {
    const int hd = item / 640, gc = item - hd * 640;
    const int base = gc < 512 ? (gc >> 7) * 2048 + 16 * (gc & 127) : MP + 8 * (gc - 512);
    const int nvalid = gc < 512 ? 16 : 8;
    unsigned char* rec = C.ws + WS_RWP + (size_t)item * RWREC;
    const float* DW = WSP(float, WS_DW); const bf16_t* R = WSP(bf16_t, WS_R); const bf16_t* KK = WSP(bf16_t, WS_KK); const bf16_t* BB = WSP(bf16_t, WS_BB);
    const bf16_t* KP = WSP(bf16_t, WS_KP); const bf16_t* VB = WSP(bf16_t, WS_VB) + (size_t)l * M * 1024;
    constexpr int AH = 0, RH = 2304, BH = 4608, KH = 6912, NB = 9216, XB = 10240, PBF = 11264, AKB = 12288;
    const int fr = lane & 15, fq = lane >> 4;
    float g = 1.f; float bh[16], kh[16]; unsigned vp[8]; unsigned rhp[8];
    float dv[16]; unsigned kkv[16], bbv[16], kpv[16], rv[16], vv[16];
#pragma unroll
    for (int t = 0; t < 16; ++t) { const size_t o = (size_t)(base + (t < nvalid ? t : nvalid - 1)) * 1024 + hd * 64 + lane;
        dv[t] = DW[o]; kkv[t] = KK[o]; bbv[t] = BB[o]; kpv[t] = KP[o]; rv[t] = R[o]; vv[t] = VB[o]; }
    __builtin_amdgcn_sched_barrier(0);
#pragma unroll
    for (int t = 0; t < 16; ++t) {
        const bool ok = t < nvalid;
        const float d = ok ? dv[t] : 1.f, kk = ok ? bf2f((bf16_t)kkv[t]) : 0.f, bb = ok ? bf2f((bf16_t)bbv[t]) : 0.f, kp = ok ? bf2f((bf16_t)kpv[t]) : 0.f, r = ok ? bf2f((bf16_t)rv[t]) : 0.f;
        const unsigned vbits = ok ? vv[t] : 0u;
        const float ah = -kk * g; g *= d; const float ig = rcpf_(g);
        bh[t] = bb * ig; kh[t] = kp * ig;
        const unsigned pa = pk2(ah, r * g), pb = pk2(bh[t], kh[t]);
        *(LAS bf16_t*)(wl + AH + t * 144 + lane * 2) = (bf16_t)(pa & 0xffff);
        *(LAS bf16_t*)(wl + RH + t * 144 + lane * 2) = (bf16_t)(pa >> 16);
        *(LAS bf16_t*)(wl + BH + t * 144 + lane * 2) = (bf16_t)(pb & 0xffff);
        *(LAS bf16_t*)(wl + KH + t * 144 + lane * 2) = (bf16_t)(pb >> 16);
        if (t & 1) { vp[t >> 1] |= vbits << 16; rhp[t >> 1] |= pa & 0xffff0000u; } else { vp[t >> 1] = vbits; rhp[t >> 1] = pa >> 16; }
    }
#pragma unroll
    for (int t = 0; t < 16; ++t) *(bf16_t*)(rec + RO_RH + t * 144 + lane * 2) = (bf16_t)((t & 1) ? (rhp[t >> 1] >> 16) : (rhp[t >> 1] & 0xffff));
    *(float*)(rec + RO_GC + lane * 4) = g;
    { u32x4 w0, w1, w2, w3;
      w0.x = pk2(bh[0] * g, bh[1] * g); w0.y = pk2(bh[2] * g, bh[3] * g); w0.z = pk2(bh[4] * g, bh[5] * g); w0.w = pk2(bh[6] * g, bh[7] * g);
      w1.x = pk2(bh[8] * g, bh[9] * g); w1.y = pk2(bh[10] * g, bh[11] * g); w1.z = pk2(bh[12] * g, bh[13] * g); w1.w = pk2(bh[14] * g, bh[15] * g);
      w2.x = pk2(kh[0] * g, kh[1] * g); w2.y = pk2(kh[2] * g, kh[3] * g); w2.z = pk2(kh[4] * g, kh[5] * g); w2.w = pk2(kh[6] * g, kh[7] * g);
      w3.x = pk2(kh[8] * g, kh[9] * g); w3.y = pk2(kh[10] * g, kh[11] * g); w3.z = pk2(kh[12] * g, kh[13] * g); w3.w = pk2(kh[14] * g, kh[15] * g);
      u32x4* bk = (u32x4*)(rec + RO_BK + lane * 64); bk[0] = w0; bk[1] = w1; bk[2] = w2; bk[3] = w3;
      u32x4 v0, v1; v0.x = vp[0]; v0.y = vp[1]; v0.z = vp[2]; v0.w = vp[3]; v1.x = vp[4]; v1.y = vp[5]; v1.z = vp[6]; v1.w = vp[7];
      u32x4* vt = (u32x4*)(rec + RO_VT + lane * 32); vt[0] = v0; vt[1] = v1; }
    LDS_WAIT();
    f32x4 aN = (f32x4){0.f, 0.f, 0.f, 0.f}, aAK = aN, aBR = aN, aKR = aN;
#pragma unroll
    for (int ks = 0; ks < 2; ++ks) { const int ko = (32 * ks + 8 * fq) * 2;
        const bf16x8 fb = ldfrag(wl, BH + fr * 144 + ko), fk = ldfrag(wl, KH + fr * 144 + ko), fa = ldfrag(wl, AH + fr * 144 + ko), frr = ldfrag(wl, RH + fr * 144 + ko);
        aN = MFMA16(fb, fa, aN); aAK = MFMA16(fk, fa, aAK); aBR = MFMA16(fb, frr, aBR); aKR = MFMA16(fk, frr, aKR); }
    f32x4 pacc;
#pragma unroll
    for (int r = 0; r < 4; ++r) { const int sidx = 4 * fq + r;
        if (sidx >= fr) { aN[r] = 0.f; aAK[r] = 0.f; }
        if (sidx > fr) { aBR[r] = 0.f; aKR[r] = 0.f; }
        pacc[r] = aN[r] + (sidx == fr ? 1.f : 0.f); }
    *(u32x2*)(rec + RO_BKR + fr * 64 + 8 * fq) = pack4(aBR[0], aBR[1], aBR[2], aBR[3]);
    *(u32x2*)(rec + RO_BKR + fr * 64 + 32 + 8 * fq) = pack4(aKR[0], aKR[1], aKR[2], aKR[3]);
    LAS float* Nb = (LAS float*)(wl + NB); LAS float* Xb = (LAS float*)(wl + XB); LAS float* Pb = (LAS float*)(wl + PBF); LAS float* AKb = (LAS float*)(wl + AKB);
    st16f(Nb, aN, fr, fq); st16f(Pb, pacc, fr, fq); st16f(AKb, aAK, fr, fq);
    LDS_WAIT();
    const f32x4 z4 = (f32x4){0.f, 0.f, 0.f, 0.f};
    f32x4 x = mm16f(Nb, Nb, z4, fr, fq); st16f(Xb, x, fr, fq); LDS_WAIT();
    pacc = mm16f(Pb, Xb, pacc, fr, fq); LDS_WAIT(); st16f(Pb, pacc, fr, fq);
    x = mm16f(Xb, Xb, z4, fr, fq); LDS_WAIT(); st16f(Nb, x, fr, fq); LDS_WAIT();
    pacc = mm16f(Pb, Nb, pacc, fr, fq); LDS_WAIT(); st16f(Pb, pacc, fr, fq);
    x = mm16f(Nb, Nb, z4, fr, fq); LDS_WAIT(); st16f(Xb, x, fr, fq); LDS_WAIT();
    pacc = mm16f(Pb, Xb, pacc, fr, fq); LDS_WAIT(); st16f(Pb, pacc, fr, fq); LDS_WAIT();
#pragma unroll
    for (int jt = 0; jt < 4; ++jt) { f32x4 acc = z4;
#pragma unroll
        for (int kk = 0; kk < 4; ++kk) { const float a = bf2f(*(const LAS bf16_t*)(wl + AH + (4 * kk + fq) * 144 + (16 * jt + fr) * 2)); acc = __builtin_amdgcn_mfma_f32_16x16x4f32(a, Pb[(4 * kk + fq) * 16 + fr], acc, 0, 0, 0); }
        *(u32x2*)(rec + RO_AT + fr * 144 + (16 * jt + 4 * fq) * 2) = pack4(acc[0], acc[1], acc[2], acc[3]); }
    { const f32x4 acc = mm16f(AKb, Pb, z4, fr, fq);
      *(u32x2*)(rec + RO_M1 + fr * 64 + 8 * fq) = (u32x2){0u, 0u};
      *(u32x2*)(rec + RO_M1 + fr * 64 + 32 + 8 * fq) = pack4(acc[0], acc[1], acc[2], acc[3]); }
    LDS_WAIT();
}
__device__ __forceinline__ void phase2b(const Params& P, const Ctx& C, int l) {
    int lane = C.lane; asm volatile("" : "+v"(lane));
    LAS unsigned char* wl = C.lds + C.wave * 13312;
    const int gw = C.wave * C.G + C.bid, NGW = C.G * 8;
    for (int item = gw; item < 10240; item += NGW) rwkv_prep_item(P, C, l, item, wl, lane);
}
__device__ __forceinline__ void rwkv_task(const Params& P, const Ctx& C, int l, int sq, int hd) {
    int tid = C.tid; asm volatile("" : "+v"(tid)); const SeqInfo si = seq_info(sq); const int lane = tid & 63, w = C.wave, fr = lane & 15, fq = lane >> 4;
    LAS unsigned char* lds = C.lds;
    constexpr int REC0 = 0, BATCH = 4 * (int)RWREC, S0B = 2 * BATCH, UVB = S0B + 9216;
    const float* S0 = si.prompt ? nullptr : P.in[3] + (((size_t)l * 128 + si.b) * 16 + hd) * 4096;
    float* Sout = si.prompt ? C.out + OFF_RWP + (((size_t)l * 4 + si.b) * 16 + hd) * 4096 : C.out + OFF_RWS + (((size_t)l * 128 + si.b) * 16 + hd) * 4096;
    bf16_t* YRW = WSP(bf16_t, WS_YRW);
    const int nchunk = si.prompt ? 128 : 1, gc0 = si.prompt ? sq * 128 : 512 + (sq - 4);
    const unsigned char* recg = C.ws + WS_RWP + (size_t)(hd * 640 + gc0) * RWREC;
    const int it = w;
    f32x4 sacc[4];
    if (w < 4) {
#pragma unroll
        for (int jt = 0; jt < 4; ++jt) { sacc[jt] = S0 ? *(const f32x4*)(S0 + (size_t)(16 * it + fr) * 64 + 16 * jt + 4 * fq) : (f32x4){0.f, 0.f, 0.f, 0.f};
            *(LAS u32x2*)(lds + S0B + (16 * it + fr) * 144 + (16 * jt + 4 * fq) * 2) = pack4(sacc[jt][0], sacc[jt][1], sacc[jt][2], sacc[jt][3]); }
        *(LAS u32x2*)(lds + UVB + (16 * it + fr) * 32 + 8 * fq) = (u32x2){0u, 0u};
    }
    const int nb = (nchunk + 3) >> 2;
    const int tl = tid - 256;
    u32x4 ra[13], rb[13];
#define RW_NP(bi) (((nchunk - 4 * (bi)) < 4 ? (nchunk - 4 * (bi)) : 4) * (int)(RWREC / 16))
#define RW_GLOAD(R, bi) do { const int np_ = RW_NP(bi); const u32x4* src_ = (const u32x4*)(recg + (size_t)(bi) * BATCH); _Pragma("unroll") for (int q = 0; q < 13; ++q) { const int pi = tl + 256 * q; R[q] = src_[pi < np_ ? pi : np_ - 1]; } } while (0)
#define RW_LWRITE(R, bi) do { const int np_ = RW_NP(bi); LAS u32x4* dst_ = (LAS u32x4*)(lds + REC0 + ((bi) & 1) * BATCH); _Pragma("unroll") for (int q = 0; q < 13; ++q) { const int pi = tl + 256 * q; if (pi < np_) dst_[pi] = R[q]; } } while (0)
    if (w >= 4) {
        RW_GLOAD(ra, 0); if (nb > 1) RW_GLOAD(rb, 1); RW_LWRITE(ra, 0);
        __syncthreads();
        for (int bi = 0; bi < nb; ++bi) {
            if ((bi & 1) == 0) { if (bi + 2 < nb) RW_GLOAD(ra, bi + 2); if (bi + 1 < nb) RW_LWRITE(rb, bi + 1); }
            else               { if (bi + 2 < nb) RW_GLOAD(rb, bi + 2); if (bi + 1 < nb) RW_LWRITE(ra, bi + 1); }
            __syncthreads();
        }
    } else {
        __syncthreads();
        const int so = S0B + (16 * it + fr) * 144, uo = UVB + (16 * it + fr) * 32;
        for (int bi = 0; bi < nb; ++bi) {
            const int ncb = (nchunk - 4 * bi) < 4 ? (nchunk - 4 * bi) : 4;
            for (int c = 0; c < ncb; ++c) {
                const LAS unsigned char* rec = lds + REC0 + (bi & 1) * BATCH + c * (int)RWREC;
                const bf16x8 at0 = ldfrag(rec, RO_AT + fr * 144 + 16 * fq), at1 = ldfrag(rec, RO_AT + fr * 144 + 64 + 16 * fq);
                const bf16x8 s0 = ldfrag(lds, so + 16 * fq), s1 = ldfrag(lds, so + 64 + 16 * fq);
                const bf16x8 m1 = ldfrag(rec, RO_M1 + fr * 64 + fq * 16), vfrag = ldfrag(rec, RO_VT + (16 * it + fr) * 32 + (fq & 1) * 16), uold = ldfrag(lds, uo + (fq & 1) * 16);
                const bf16x8 rh0 = ldfrag(rec, RO_RH + fr * 144 + 16 * fq), rh1 = ldfrag(rec, RO_RH + fr * 144 + 64 + 16 * fq), bkr = ldfrag(rec, RO_BKR + fr * 64 + fq * 16);
                bf16x8 bk[4]; f32x4 g4[4];
#pragma unroll
                for (int jt = 0; jt < 4; ++jt) { bk[jt] = ldfrag(rec, RO_BK + (16 * jt + fr) * 64 + fq * 16); g4[jt] = *(const LAS f32x4*)(rec + RO_GC + (16 * jt + 4 * fq) * 4); }
                __builtin_amdgcn_sched_barrier(0);
                f32x4 au = (f32x4){0.f, 0.f, 0.f, 0.f};
                au = MFMA16(at0, s0, au); au = MFMA16(at1, s1, au); au = MFMA16(m1, fq < 2 ? uold : vfrag, au);
                f32x4 ay = (f32x4){0.f, 0.f, 0.f, 0.f};
                ay = MFMA16(s0, rh0, ay); ay = MFMA16(s1, rh1, ay);
#pragma unroll
                for (int jt = 0; jt < 4; ++jt) sacc[jt] *= g4[jt];
                asm volatile("" ::: "memory");
                *(LAS u32x2*)(lds + uo + 8 * fq) = pack4(au[0], au[1], au[2], au[3]);
                asm volatile("" ::: "memory");
                const bf16x8 unew = ldfrag(lds, uo + (fq & 1) * 16);
                const bf16x8 uv = fq < 2 ? unew : vfrag;
#pragma unroll
                for (int jt = 0; jt < 4; ++jt) sacc[jt] = MFMA16(bk[jt], uv, sacc[jt]);
                ay = MFMA16(uv, bkr, ay);
#pragma unroll
                for (int jt = 0; jt < 4; ++jt) *(LAS u32x2*)(lds + so + (16 * jt + 4 * fq) * 2) = pack4(sacc[jt][0], sacc[jt][1], sacc[jt][2], sacc[jt][3]);
                const int tl = 16 * (4 * bi + c) + fr;
                if (tl < si.T) *(u32x2*)(YRW + (size_t)(si.base + tl) * 1024 + hd * 64 + 16 * it + 4 * fq) = pack4(ay[0], ay[1], ay[2], ay[3]);
                asm volatile("" ::: "memory");
            }
            __syncthreads();
        }
    }
#undef RW_NP
#undef RW_GLOAD
#undef RW_LWRITE
    if (w < 4) {
#pragma unroll
        for (int jt = 0; jt < 4; ++jt) *(f32x4*)(Sout + (size_t)(16 * it + fr) * 64 + 16 * jt + 4 * fq) = sacc[jt];
    }
}

__device__ __forceinline__ void rwkv_s_task(const Params& P, const Ctx& C, int l, int sq, int hq) {
    int tid = C.tid; asm volatile("" : "+v"(tid)); const SeqInfo si = seq_info(sq); const int lane = tid & 63, w = C.wave, fr = lane & 15, fq = lane >> 4;
    LAS unsigned char* lds = C.lds;
    constexpr int REC0 = 0, SLOT = 13056, S0B = 2 * SLOT, UVB = S0B + 9216;
    bf16_t* YRW = WSP(bf16_t, WS_YRW);
    const int gc = 512 + (sq - 4), it = w, tl = tid - 256;
    u32x4 rr[4];
#define RS_GLOAD(hd_) do { const u32x4* src_ = (const u32x4*)(C.ws + WS_RWP + (size_t)((hd_) * 640 + gc) * RWREC); _Pragma("unroll") for (int q = 0; q < 4; ++q) { const int pi = tl + 256 * q; rr[q] = src_[pi < 816 ? pi : 815]; } } while (0)
#define RS_LWRITE(slot_) do { LAS u32x4* dst_ = (LAS u32x4*)(lds + REC0 + (slot_) * SLOT); _Pragma("unroll") for (int q = 0; q < 4; ++q) { const int pi = tl + 256 * q; if (pi < 816) dst_[pi] = rr[q]; } } while (0)
    f32x4 nxt[4];
    if (w >= 4) { RS_GLOAD(4 * hq); RS_LWRITE(0); }
    else {
        const float* S0 = P.in[3] + (((size_t)l * 128 + si.b) * 16 + 4 * hq) * 4096;
#pragma unroll
        for (int jt = 0; jt < 4; ++jt) nxt[jt] = *(const f32x4*)(S0 + (size_t)(16 * it + fr) * 64 + 16 * jt + 4 * fq);
        *(LAS u32x2*)(lds + UVB + (16 * it + fr) * 32 + 8 * fq) = (u32x2){0u, 0u};
    }
    __syncthreads();
#pragma unroll 1
    for (int hh0 = 0; hh0 < 4; ++hh0) {
        int hh = hh0; asm volatile("" : "+s"(hh));
        const int hd = 4 * hq + hh;
        if (w >= 4) { if (hh < 3) { RS_GLOAD(hd + 1); RS_LWRITE((hh + 1) & 1); } }
        else {
            f32x4 sacc[4];
#pragma unroll
            for (int jt = 0; jt < 4; ++jt) { sacc[jt] = nxt[jt];
                *(LAS u32x2*)(lds + S0B + (16 * it + fr) * 144 + (16 * jt + 4 * fq) * 2) = pack4(sacc[jt][0], sacc[jt][1], sacc[jt][2], sacc[jt][3]); }
            if (hh < 3) { const float* S1 = P.in[3] + (((size_t)l * 128 + si.b) * 16 + hd + 1) * 4096;
#pragma unroll
                for (int jt = 0; jt < 4; ++jt) nxt[jt] = *(const f32x4*)(S1 + (size_t)(16 * it + fr) * 64 + 16 * jt + 4 * fq); }
            const LAS unsigned char* rec = lds + REC0 + (hh & 1) * SLOT;
            const int so = S0B + (16 * it + fr) * 144, uo = UVB + (16 * it + fr) * 32;
            f32x4 au = (f32x4){0.f, 0.f, 0.f, 0.f};
#pragma unroll
            for (int ks = 0; ks < 2; ++ks) au = MFMA16(ldfrag(rec, RO_AT + fr * 144 + (32 * ks + 8 * fq) * 2), ldfrag(lds, so + (32 * ks + 8 * fq) * 2), au);
            const bf16x8 vfrag = ldfrag(rec, RO_VT + (16 * it + fr) * 32 + (fq & 1) * 16);
            { const bf16x8 uold = ldfrag(lds, uo + (fq & 1) * 16); au = MFMA16(ldfrag(rec, RO_M1 + fr * 64 + fq * 16), fq < 2 ? uold : vfrag, au); }
            asm volatile("" ::: "memory");
            *(LAS u32x2*)(lds + uo + 8 * fq) = pack4(au[0], au[1], au[2], au[3]);
            asm volatile("" ::: "memory");
            const bf16x8 unew = ldfrag(lds, uo + (fq & 1) * 16);
            const bf16x8 uv = fq < 2 ? unew : vfrag;
            f32x4 ay = (f32x4){0.f, 0.f, 0.f, 0.f};
#pragma unroll
            for (int ks = 0; ks < 2; ++ks) ay = MFMA16(ldfrag(lds, so + (32 * ks + 8 * fq) * 2), ldfrag(rec, RO_RH + fr * 144 + (32 * ks + 8 * fq) * 2), ay);
            ay = MFMA16(uv, ldfrag(rec, RO_BKR + fr * 64 + fq * 16), ay);
            if (fr < si.T) *(u32x2*)(YRW + (size_t)(si.base + fr) * 1024 + hd * 64 + 16 * it + 4 * fq) = pack4(ay[0], ay[1], ay[2], ay[3]);
            float* Sout = C.out + OFF_RWS + (((size_t)l * 128 + si.b) * 16 + hd) * 4096;
#pragma unroll
            for (int jt = 0; jt < 4; ++jt) { const f32x4 g4 = *(const LAS f32x4*)(rec + RO_GC + (16 * jt + 4 * fq) * 4); sacc[jt] *= g4;
                sacc[jt] = MFMA16(ldfrag(rec, RO_BK + (16 * jt + fr) * 64 + fq * 16), uv, sacc[jt]);
                *(f32x4*)(Sout + (size_t)(16 * it + fr) * 64 + 16 * jt + 4 * fq) = sacc[jt]; }
        }
        __syncthreads();
    }
#undef RS_GLOAD
#undef RS_LWRITE
}
constexpr int HQA = 0, HQS = 17408, HKD = 34816, HKST = 52224, HVT = 70656, HPB = 89088, HST = 98304, HSEG = 133120, HEBL = 137216;
constexpr size_t HREC = 50688;
__device__ __forceinline__ void hgrn_stage_att(const Params& P, const Ctx& C, int l, const SeqInfo& si, int h, int n, int nti, int tid, int w, int fr, int fq) {
    LAS unsigned char* lds = C.lds; const bf16_t* Z = WSP(bf16_t, WS_Z);
    const int k2 = tid & 63, seg = tid >> 6;
    float lb0 = 0.f, lb1 = 0.f;
    if (l == 1) { const float* hl = P.in[10]; const int cc = h * 128 + 2 * k2; lb0 = sigm(hl[1024 + cc] - hl[cc]); lb1 = sigm(hl[1024 + cc + 1] - hl[cc + 1]); }
    float lf[8][2], kk[8][2], qq[8][2], vv[8][2];
#pragma unroll
    for (int j = 0; j < 8; ++j) { lf[j][0] = lf[j][1] = 0.f; kk[j][0] = kk[j][1] = 0.f; qq[j][0] = qq[j][1] = 0.f; vv[j][0] = vv[j][1] = 0.f; }
    if (64 * n + 8 * seg < si.T) {
      unsigned zq[8], zf[8], zi[8];
#pragma unroll
      for (int j = 0; j < 8; ++j) { const bf16_t* zr = Z + (size_t)(si.base + 64 * n + 8 * seg + j) * NPAD + h * 128 + 2 * k2; zq[j] = *(const unsigned*)(zr + ZHQ); zf[j] = *(const unsigned*)(zr + ZHF); zi[j] = *(const unsigned*)(zr + ZHI); }
      __builtin_amdgcn_sched_barrier(0);
#pragma unroll
      for (int j = 0; j < 8; ++j) { const unsigned hq = zq[j], hf = zf[j], hi = zi[j];
        { const float sg = sigm(bflo(hf)); const float f = lb0 + (1.f - lb0) * sg; lf[j][0] = __logf(fmaxf(f, 1e-30f)); kk[j][0] = (1.f - lb0) * (1.f - sg); qq[j][0] = siluf(bflo(hq)) * 0.08838834764831845f; vv[j][0] = bflo(hi); }
        { const float sg = sigm(bfhi(hf)); const float f = lb1 + (1.f - lb1) * sg; lf[j][1] = __logf(fmaxf(f, 1e-30f)); kk[j][1] = (1.f - lb1) * (1.f - sg); qq[j][1] = siluf(bfhi(hq)) * 0.08838834764831845f; vv[j][1] = bfhi(hi); } }
    }
#pragma unroll
    for (int j = 1; j < 8; ++j) { lf[j][0] += lf[j - 1][0]; lf[j][1] += lf[j - 1][1]; }
    *(LAS f32x2*)(lds + HSEG + (seg * 128 + 2 * k2) * 4) = (f32x2){lf[7][0], lf[7][1]};
    __syncthreads();
    float pre0 = 0.f, pre1 = 0.f, tot0 = 0.f, tot1 = 0.f, r10 = 0.f, r11 = 0.f;
#pragma unroll
    for (int s = 0; s < 8; ++s) { const f32x2 v = *(const LAS f32x2*)(lds + HSEG + (s * 128 + 2 * k2) * 4); if (s < seg) { pre0 += v.x; pre1 += v.y; } if (s < 4) { r10 += v.x; r11 += v.y; } tot0 += v.x; tot1 += v.y; }
    const float rb0 = seg >= 4 ? r10 : 0.f, rb1 = seg >= 4 ? r11 : 0.f;
    if (seg == 0) *(LAS f32x2*)(lds + HEBL + 2 * k2 * 4) = (f32x2){__expf(tot0), __expf(tot1)};
    if (64 * n + 8 * seg < si.T) {
        const float er0 = __expf(rb0), er1 = __expf(rb1);
        float ks[8][2];
#pragma unroll
        for (int j = 0; j < 8; ++j) { const int t = 8 * seg + j; const float b0 = pre0 + lf[j][0], b1 = pre1 + lf[j][1];
            const float e0 = __expf(b0 - rb0), e1 = __expf(b1 - rb1);
            *(LAS unsigned*)(lds + HQA + t * 272 + k2 * 4) = pk2(qq[j][0] * e0, qq[j][1] * e1);
            *(LAS unsigned*)(lds + HQS + t * 272 + k2 * 4) = pk2(qq[j][0] * e0 * er0, qq[j][1] * e1 * er1);
            *(LAS unsigned*)(lds + HKD + t * 272 + k2 * 4) = pk2(kk[j][0] * rcpf_(e0), kk[j][1] * rcpf_(e1));
            ks[j][0] = kk[j][0] * __expf(tot0 - b0); ks[j][1] = kk[j][1] * __expf(tot1 - b1); }
        { u32x4 a, b, c, d;
          a.x = pk2(ks[0][0], ks[1][0]); a.y = pk2(ks[2][0], ks[3][0]); a.z = pk2(ks[4][0], ks[5][0]); a.w = pk2(ks[6][0], ks[7][0]);
          b.x = pk2(ks[0][1], ks[1][1]); b.y = pk2(ks[2][1], ks[3][1]); b.z = pk2(ks[4][1], ks[5][1]); b.w = pk2(ks[6][1], ks[7][1]);
          c.x = pk2(vv[0][0], vv[1][0]); c.y = pk2(vv[2][0], vv[3][0]); c.z = pk2(vv[4][0], vv[5][0]); c.w = pk2(vv[6][0], vv[7][0]);
          d.x = pk2(vv[0][1], vv[1][1]); d.y = pk2(vv[2][1], vv[3][1]); d.z = pk2(vv[4][1], vv[5][1]); d.w = pk2(vv[6][1], vv[7][1]);
          *(LAS u32x4*)(lds + HKST + (2 * k2) * 144 + 16 * seg) = a; *(LAS u32x4*)(lds + HKST + (2 * k2 + 1) * 144 + 16 * seg) = b;
          *(LAS u32x4*)(lds + HVT + (2 * k2) * 144 + 16 * seg) = c; *(LAS u32x4*)(lds + HVT + (2 * k2 + 1) * 144 + 16 * seg) = d; }
    } else {
#pragma unroll
        for (int j = 0; j < 8; ++j) { const int t = 8 * seg + j; *(LAS unsigned*)(lds + HQA + t * 272 + k2 * 4) = 0u; *(LAS unsigned*)(lds + HQS + t * 272 + k2 * 4) = 0u; *(LAS unsigned*)(lds + HKD + t * 272 + k2 * 4) = 0u; }
        { const u32x4 z4 = (u32x4){0u, 0u, 0u, 0u};
          *(LAS u32x4*)(lds + HKST + (2 * k2) * 144 + 16 * seg) = z4; *(LAS u32x4*)(lds + HKST + (2 * k2 + 1) * 144 + 16 * seg) = z4;
          *(LAS u32x4*)(lds + HVT + (2 * k2) * 144 + 16 * seg) = z4; *(LAS u32x4*)(lds + HVT + (2 * k2 + 1) * 144 + 16 * seg) = z4; }
    }
    __syncthreads();
#pragma unroll
    for (int tt = 0; tt < 2; ++tt) { const int tile = 2 * w + tt, ti = tile >> 2, sj = tile & 3;
        if (ti < nti) {
            f32x4 acc = (f32x4){0.f, 0.f, 0.f, 0.f};
            if (sj <= ti) { const int qb = (ti >= 2 && sj < 2) ? HQS : HQA; bf16x8 kf[4], qf[4];
#pragma unroll
                for (int ks = 0; ks < 4; ++ks) { kf[ks] = ldfrag(lds, HKD + (16 * sj + fr) * 272 + (32 * ks + 8 * fq) * 2); qf[ks] = ldfrag(lds, qb + (16 * ti + fr) * 272 + (32 * ks + 8 * fq) * 2); }
                __builtin_amdgcn_sched_barrier(0);
#pragma unroll
                for (int ks = 0; ks < 4; ++ks) acc = MFMA16(kf[ks], qf[ks], acc);
                const int t = 16 * ti + fr;
#pragma unroll
                for (int r = 0; r < 4; ++r) if (16 * sj + 4 * fq + r > t) acc[r] = 0.f; }
            *(LAS u32x2*)(lds + HPB + (16 * ti + fr) * 144 + (16 * sj + 4 * fq) * 2) = pack4(acc[0], acc[1], acc[2], acc[3]); } }
    __syncthreads();
}
__device__ __forceinline__ void hgrn_a_item(const Params& P, const Ctx& C, int l, int item) {
    int tid = C.tid; asm volatile("" : "+v"(tid)); const int lane = tid & 63, w = C.wave, fr = lane & 15, fq = lane >> 4;
    const int n = item & 31, h = (item >> 5) & 7, sq = item >> 8;
    const SeqInfo si = seq_info(sq); LAS unsigned char* lds = C.lds; bf16_t* OHG = WSP(bf16_t, WS_OHG);
    unsigned char* rec = C.ws + WS_HREC + (size_t)item * HREC;
    hgrn_stage_att(P, C, l, si, h, n, 4, tid, w, fr, fq);
    { bf16x8 vf[2], pf[4][2];
#pragma unroll
      for (int ks = 0; ks < 2; ++ks) { vf[ks] = ldfrag(lds, HVT + (16 * w + fr) * 144 + (32 * ks + 8 * fq) * 2);
#pragma unroll
          for (int ti = 0; ti < 4; ++ti) pf[ti][ks] = ldfrag(lds, HPB + (16 * ti + fr) * 144 + (32 * ks + 8 * fq) * 2); }
      __builtin_amdgcn_sched_barrier(0);
#pragma unroll
      for (int ti = 0; ti < 4; ++ti) { f32x4 acc = (f32x4){0.f, 0.f, 0.f, 0.f};
#pragma unroll
          for (int ks = 0; ks < 2; ++ks) acc = MFMA16(vf[ks], pf[ti][ks], acc);
          *(u32x2*)(OHG + (size_t)(si.base + 64 * n + 16 * ti + fr) * 1024 + h * 128 + 16 * w + 4 * fq) = pack4(acc[0], acc[1], acc[2], acc[3]); }
      bf16x8 af[8][2];
#pragma unroll
      for (int kt = 0; kt < 8; ++kt)
#pragma unroll
          for (int ks = 0; ks < 2; ++ks) af[kt][ks] = ldfrag(lds, HKST + (16 * kt + fr) * 144 + (32 * ks + 8 * fq) * 2);
      __builtin_amdgcn_sched_barrier(0);
#pragma unroll
      for (int kt = 0; kt < 8; ++kt) { f32x4 acc = (f32x4){0.f, 0.f, 0.f, 0.f};
#pragma unroll
          for (int ks = 0; ks < 2; ++ks) acc = MFMA16(af[kt][ks], vf[ks], acc);
          *(u32x2*)(rec + 17920 + ((size_t)(kt * 128 + 16 * w + fr) * 16 + 4 * fq) * 2) = pack4(acc[0], acc[1], acc[2], acc[3]); } }
    for (int i = tid; i < 1120; i += NTHREADS) ((u32x4*)rec)[i] = *(const LAS u32x4*)(lds + (i < 1088 ? HQS + i * 16 : HEBL + (i - 1088) * 16));
    __syncthreads();
}
__device__ __forceinline__ void hgrn_b_task(const Params& P, const Ctx& C, int l, int sq, int h) {
    int tid = C.tid; asm volatile("" : "+v"(tid)); const int lane = tid & 63, w = C.wave, fr = lane & 15, fq = lane >> 4;
    const SeqInfo si = seq_info(sq); LAS unsigned char* lds = C.lds; bf16_t* OHG = WSP(bf16_t, WS_OHG);
    float* Sout = C.out + OFF_HGP + (((size_t)l * 4 + si.b) * 8 + h) * 16384;
    const unsigned char* rec0 = C.ws + WS_HREC + (size_t)((sq * 8 + h) * 32) * HREC;
    f32x4 sacc[8];
#pragma unroll
    for (int kt = 0; kt < 8; ++kt) { sacc[kt] = (f32x4){0.f, 0.f, 0.f, 0.f}; *(LAS u32x2*)(lds + HST + (16 * w + fr) * 272 + (16 * kt + 4 * fq) * 2) = (u32x2){0u, 0u}; }
    u32x4 pq[3];
    auto gq = [&](int n) { const u32x4* src = (const u32x4*)(rec0 + (size_t)n * HREC);
#pragma unroll
        for (int q = 0; q < 3; ++q) { const int i = tid + 512 * q; pq[q] = src[i < 1088 ? i : 1087]; } };
    auto lq = [&](int n) { LAS u32x4* dst = (LAS u32x4*)(lds + ((n & 1) ? HQS : HQA));
#pragma unroll
        for (int q = 0; q < 3; ++q) { const int i = tid + 512 * q; if (i < 1088) dst[i] = pq[q]; } };
    gq(0); lq(0);
    __syncthreads();
    for (int n = 0; n < 32; ++n) {
        const unsigned char* rec = rec0 + (size_t)n * HREC;
        if (n + 1 < 32) gq(n + 1);
        u32x2 Lr[8]; f32x4 eb[8];
#pragma unroll
        for (int kt = 0; kt < 8; ++kt) { Lr[kt] = *(const u32x2*)(rec + 17920 + ((size_t)(kt * 128 + 16 * w + fr) * 16 + 4 * fq) * 2); eb[kt] = *(const f32x4*)(rec + 17408 + (16 * kt + 4 * fq) * 4); }
        const int qb = (n & 1) ? HQS : HQA;
        bf16_t* op0 = OHG + (size_t)(si.base + 64 * n + fr) * 1024 + h * 128 + 16 * w + 4 * fq;
        u32x2 oraw[4]; f32x4 oacc[4];
#pragma unroll
        for (int ti = 0; ti < 4; ++ti) oraw[ti] = *(const u32x2*)(op0 + (size_t)ti * 16 * 1024);
        { bf16x8 sf[4];
#pragma unroll
          for (int ks = 0; ks < 4; ++ks) sf[ks] = ldfrag(lds, HST + (16 * w + fr) * 272 + (32 * ks + 8 * fq) * 2);
#pragma unroll
          for (int tp = 0; tp < 2; ++tp) { bf16x8 qf[2][4];
#pragma unroll
              for (int t2 = 0; t2 < 2; ++t2)
#pragma unroll
                  for (int ks = 0; ks < 4; ++ks) qf[t2][ks] = ldfrag(lds, qb + (16 * (2 * tp + t2) + fr) * 272 + (32 * ks + 8 * fq) * 2);
              __builtin_amdgcn_sched_barrier(0);
#pragma unroll
              for (int t2 = 0; t2 < 2; ++t2) { f32x4 acc = (f32x4){0.f, 0.f, 0.f, 0.f};
#pragma unroll
                  for (int ks = 0; ks < 4; ++ks) acc = MFMA16(sf[ks], qf[t2][ks], acc);
                  oacc[2 * tp + t2] = acc; } } }
        asm volatile("" ::: "memory");
#pragma unroll
        for (int kt = 0; kt < 8; ++kt) { float l4[4]; unpack4(Lr[kt], l4); sacc[kt] = sacc[kt] * eb[kt] + (f32x4){l4[0], l4[1], l4[2], l4[3]};
            *(LAS u32x2*)(lds + HST + (16 * w + fr) * 272 + (16 * kt + 4 * fq) * 2) = pack4(sacc[kt][0], sacc[kt][1], sacc[kt][2], sacc[kt][3]); }
#pragma unroll
        for (int ti = 0; ti < 4; ++ti) { float o4[4]; unpack4(oraw[ti], o4); *(u32x2*)(op0 + (size_t)ti * 16 * 1024) = pack4(oacc[ti][0] + o4[0], oacc[ti][1] + o4[1], oacc[ti][2] + o4[2], oacc[ti][3] + o4[3]); }
        if (n + 1 < 32) lq(n + 1);
        __syncthreads();
    }
#pragma unroll
    for (int kt = 0; kt < 8; ++kt)
#pragma unroll
        for (int r = 0; r < 4; ++r) Sout[(size_t)(16 * kt + 4 * fq + r) * 128 + 16 * w + fr] = sacc[kt][r];
}
__device__ __forceinline__ void hgrn_task(const Params& P, const Ctx& C, int l, int sq, int hq) {
    int tid = C.tid; asm volatile("" : "+v"(tid)); const SeqInfo si = seq_info(sq); const int lane = tid & 63, w = C.wave, fr = lane & 15, fq = lane >> 4;
    LAS unsigned char* lds = C.lds; bf16_t* OHG = WSP(bf16_t, WS_OHG);
    f32x4 nxt[8];
    { const float* S0 = P.in[2] + (((size_t)l * 128 + si.b) * 8 + 4 * hq) * 16384;
#pragma unroll
      for (int kt = 0; kt < 8; ++kt)
#pragma unroll
        for (int r = 0; r < 4; ++r) nxt[kt][r] = S0[(size_t)(16 * kt + 4 * fq + r) * 128 + 16 * w + fr]; }
#pragma unroll 1
    for (int hh0 = 0; hh0 < 4; ++hh0) {
        int hh = hh0; asm volatile("" : "+s"(hh));
        const int h = 4 * hq + hh;
        float* Sout = C.out + OFF_HGS + (((size_t)l * 128 + si.b) * 8 + h) * 16384;
        f32x4 sacc[8];
#pragma unroll
        for (int kt = 0; kt < 8; ++kt) { sacc[kt] = nxt[kt];
            *(LAS u32x2*)(lds + HST + (16 * w + fr) * 272 + (16 * kt + 4 * fq) * 2) = pack4(sacc[kt][0], sacc[kt][1], sacc[kt][2], sacc[kt][3]); }
        hgrn_stage_att(P, C, l, si, h, 0, 1, tid, w, fr, fq);
        if (hh < 3) { const float* S1 = P.in[2] + (((size_t)l * 128 + si.b) * 8 + h + 1) * 16384;
#pragma unroll
            for (int kt = 0; kt < 8; ++kt)
#pragma unroll
                for (int r = 0; r < 4; ++r) nxt[kt][r] = S1[(size_t)(16 * kt + 4 * fq + r) * 128 + 16 * w + fr]; }
        { f32x4 acc = (f32x4){0.f, 0.f, 0.f, 0.f};
          { const bf16x8 vf = ldfrag(lds, HVT + (16 * w + fr) * 144 + (8 * fq) * 2), pf = ldfrag(lds, HPB + fr * 144 + (8 * fq) * 2); acc = MFMA16(vf, pf, acc); }
#pragma unroll
          for (int ks = 0; ks < 4; ++ks) { const bf16x8 sf = ldfrag(lds, HST + (16 * w + fr) * 272 + (32 * ks + 8 * fq) * 2), qf = ldfrag(lds, HQS + fr * 272 + (32 * ks + 8 * fq) * 2); acc = MFMA16(sf, qf, acc); }
          if (fr < si.T) *(u32x2*)(OHG + (size_t)(si.base + fr) * 1024 + h * 128 + 16 * w + 4 * fq) = pack4(acc[0], acc[1], acc[2], acc[3]); }
#pragma unroll
        for (int kt = 0; kt < 8; ++kt) { const f32x4 e = *(const LAS f32x4*)(lds + HEBL + (16 * kt + 4 * fq) * 4); sacc[kt] *= e;
            { const bf16x8 af = ldfrag(lds, HKST + (16 * kt + fr) * 144 + (8 * fq) * 2), bf = ldfrag(lds, HVT + (16 * w + fr) * 144 + (8 * fq) * 2); sacc[kt] = MFMA16(af, bf, sacc[kt]); }
#pragma unroll
            for (int r = 0; r < 4; ++r) Sout[(size_t)(16 * kt + 4 * fq + r) * 128 + 16 * w + fr] = sacc[kt][r]; }
        __syncthreads();
    }
}

constexpr size_t RQAREC = 33792, RLREC = 131072;
__device__ __forceinline__ void ret_a_item(const Params& P, const Ctx& C, int l, int item) {
    int tid = C.tid; asm volatile("" : "+v"(tid)); const int lane = tid & 63, w = C.wave, fr = lane & 15, fq = lane >> 4;
    const int n = item & 31, h = (item >> 5) & 3, sq = item >> 7;
    const SeqInfo si = seq_info(sq); LAS unsigned char* lds = C.lds;
    constexpr int QA = 0, KA = 33792, KAT = 67584, VT = 104448, PB = 122880;
    const bf16_t* Z = WSP(bf16_t, WS_Z); bf16_t* ORN = WSP(bf16_t, WS_ORN); const f32x2* rope = WSP(f32x2, WS_ROPE);
    unsigned char* rqa = C.ws + WS_RQA + (size_t)item * RQAREC; bf16_t* rl = (bf16_t*)((unsigned char*)C.out + (size_t)item * RLREC);
    const float lg = __logf(1.f - exp2f(-5.f - (float)h));
    const int i2 = tid & 63, tq = tid >> 6;
#pragma unroll
    for (int j = 0; j < 8; j += 2) {
        float kt1[2][2], kt2[2][2];
#pragma unroll
        for (int jj = 0; jj < 2; ++jj) { const int t = 8 * tq + j + jj, tl = 64 * n + t;
            const bf16_t* zr = Z + (size_t)(si.base + tl) * NPAD + h * 256 + 2 * i2;
            const unsigned xq1 = *(const unsigned*)(zr + ZRQ), xq2 = *(const unsigned*)(zr + ZRQ + 128), xk1 = *(const unsigned*)(zr + ZRK), xk2 = *(const unsigned*)(zr + ZRK + 128);
            const f32x4 cs = *(const f32x4*)(rope + (size_t)tl * 128 + 2 * i2);
            const float q1a = bflo(xq1) * cs[0] - bflo(xq2) * cs[1], q2a = bflo(xq1) * cs[1] + bflo(xq2) * cs[0];
            const float q1b = bfhi(xq1) * cs[2] - bfhi(xq2) * cs[3], q2b = bfhi(xq1) * cs[3] + bfhi(xq2) * cs[2];
            const float k1a = (bflo(xk1) * cs[0] - bflo(xk2) * cs[1]) * 0.0625f, k2a = (bflo(xk1) * cs[1] + bflo(xk2) * cs[0]) * 0.0625f;
            const float k1b = (bfhi(xk1) * cs[2] - bfhi(xk2) * cs[3]) * 0.0625f, k2b = (bfhi(xk1) * cs[3] + bfhi(xk2) * cs[2]) * 0.0625f;
            *(LAS unsigned*)(lds + QA + t * 528 + i2 * 4) = pk2(q1a, q1b); *(LAS unsigned*)(lds + QA + t * 528 + 256 + i2 * 4) = pk2(q2a, q2b);
            *(LAS unsigned*)(lds + KA + t * 528 + i2 * 4) = pk2(k1a, k1b); *(LAS unsigned*)(lds + KA + t * 528 + 256 + i2 * 4) = pk2(k2a, k2b);
            const float kd = __expf(lg * (float)(63 - t));
            kt1[jj][0] = k1a * kd; kt1[jj][1] = k1b * kd; kt2[jj][0] = k2a * kd; kt2[jj][1] = k2b * kd; }
        const int t = 8 * tq + j;
        *(LAS unsigned*)(lds + KAT + (2 * i2) * 144 + t * 2) = pk2(kt1[0][0], kt1[1][0]);
        *(LAS unsigned*)(lds + KAT + (2 * i2 + 1) * 144 + t * 2) = pk2(kt1[0][1], kt1[1][1]);
        *(LAS unsigned*)(lds + KAT + (128 + 2 * i2) * 144 + t * 2) = pk2(kt2[0][0], kt2[1][0]);
        *(LAS unsigned*)(lds + KAT + (128 + 2 * i2 + 1) * 144 + t * 2) = pk2(kt2[0][1], kt2[1][1]);
    }
    __syncthreads();
#pragma unroll
    for (int tt = 0; tt < 2; ++tt) { const int tile = 2 * w + tt, ti = tile >> 2, sj = tile & 3;
        f32x4 acc = (f32x4){0.f, 0.f, 0.f, 0.f};
        if (sj <= ti) { bf16x8 kf[8], qf[8];
#pragma unroll
            for (int ks = 0; ks < 8; ++ks) { kf[ks] = ldfrag(lds, KA + (16 * sj + fr) * 528 + (32 * ks + 8 * fq) * 2); qf[ks] = ldfrag(lds, QA + (16 * ti + fr) * 528 + (32 * ks + 8 * fq) * 2); }
            __builtin_amdgcn_sched_barrier(0);
#pragma unroll
            for (int ks = 0; ks < 8; ++ks) acc = MFMA16(kf[ks], qf[ks], acc);
            const int t = 16 * ti + fr;
#pragma unroll
            for (int r = 0; r < 4; ++r) { const int ss = 16 * sj + 4 * fq + r; acc[r] = (ss > t) ? 0.f : acc[r] * __expf(lg * (float)(t - ss)); } }
        *(LAS u32x2*)(lds + PB + (16 * ti + fr) * 144 + (16 * sj + 4 * fq) * 2) = pack4(acc[0], acc[1], acc[2], acc[3]); }
    unsigned vpk[2][8];
    { const int v = tid & 127, tq4 = tid >> 7;
#pragma unroll
      for (int vh = 0; vh < 2; ++vh)
#pragma unroll
        for (int j = 0; j < 16; j += 2) { const int t = 16 * tq4 + j;
            const unsigned x0 = Z[(size_t)(si.base + 64 * n + t) * NPAD + ZRV + h * 256 + vh * 128 + v], x1 = Z[(size_t)(si.base + 64 * n + t + 1) * NPAD + ZRV + h * 256 + vh * 128 + v];
            vpk[vh][j >> 1] = x0 | (x1 << 16); } }
#pragma unroll
    for (int vh = 0; vh < 2; ++vh) {
        __syncthreads();
        { const int v = tid & 127, tq4 = tid >> 7;
#pragma unroll
            for (int j = 0; j < 16; j += 2) { const int t = 16 * tq4 + j; *(LAS unsigned*)(lds + VT + v * 144 + t * 2) = vpk[vh][j >> 1]; } }
        __syncthreads();
        { bf16x8 vf[2], pf[4][2];
#pragma unroll
          for (int ks = 0; ks < 2; ++ks) { vf[ks] = ldfrag(lds, VT + (16 * w + fr) * 144 + (32 * ks + 8 * fq) * 2);
#pragma unroll
              for (int ti = 0; ti < 4; ++ti) pf[ti][ks] = ldfrag(lds, PB + (16 * ti + fr) * 144 + (32 * ks + 8 * fq) * 2); }
          __builtin_amdgcn_sched_barrier(0);
#pragma unroll
          for (int ti = 0; ti < 4; ++ti) { f32x4 acc = (f32x4){0.f, 0.f, 0.f, 0.f};
#pragma unroll
              for (int ks = 0; ks < 2; ++ks) acc = MFMA16(vf[ks], pf[ti][ks], acc);
              *(u32x2*)(ORN + (size_t)(si.base + 64 * n + 16 * ti + fr) * 1024 + h * 256 + vh * 128 + 16 * w + 4 * fq) = pack4(acc[0], acc[1], acc[2], acc[3]); }
#pragma unroll
          for (int kg = 0; kg < 2; ++kg) { bf16x8 af[8][2];
#pragma unroll
              for (int kk = 0; kk < 8; ++kk)
#pragma unroll
                  for (int ks = 0; ks < 2; ++ks) af[kk][ks] = ldfrag(lds, KAT + (16 * (8 * kg + kk) + fr) * 144 + (32 * ks + 8 * fq) * 2);
              __builtin_amdgcn_sched_barrier(0);
#pragma unroll
              for (int kk = 0; kk < 8; ++kk) { const int kt = 8 * kg + kk; f32x4 acc = (f32x4){0.f, 0.f, 0.f, 0.f};
#pragma unroll
                  for (int ks = 0; ks < 2; ++ks) acc = MFMA16(af[kk][ks], vf[ks], acc);
                  *(u32x2*)(rl + ((size_t)kt * 256 + vh * 128 + 16 * w + fr) * 16 + 4 * fq) = pack4(acc[0], acc[1], acc[2], acc[3]); } } }
    }
    for (int i = tid; i < 2112; i += NTHREADS) ((u32x4*)rqa)[i] = *(const LAS u32x4*)(lds + QA + i * 16);
    __syncthreads();
}
__device__ __forceinline__ void ret_b_task(const Params& P, const Ctx& C, int l, int sq, int h, int vh) {
    int tid = C.tid; asm volatile("" : "+v"(tid)); const int lane = tid & 63, w = C.wave, fr = lane & 15, fq = lane >> 4;
    const SeqInfo si = seq_info(sq); LAS unsigned char* lds = C.lds; bf16_t* ORN = WSP(bf16_t, WS_ORN);
    constexpr int ST = 0, QB0 = 67584;
    float* Sout = C.out + OFF_RNP + (((size_t)l * 4 + si.b) * 4 + h) * 65536;
    const int item0 = (sq * 4 + h) * 32;
    const float lg = __logf(1.f - exp2f(-5.f - (float)h)); const float cdec = __expf(lg * 64.f);
    f32x4 sacc[16];
#pragma unroll
    for (int kt = 0; kt < 16; ++kt) { sacc[kt] = (f32x4){0.f, 0.f, 0.f, 0.f}; *(LAS u32x2*)(lds + ST + (16 * w + fr) * 528 + (16 * kt + 4 * fq) * 2) = (u32x2){0u, 0u}; }
    u32x4 pq[5];
    auto gq = [&](int n) { const u32x4* src = (const u32x4*)(C.ws + WS_RQA + (size_t)(item0 + n) * RQAREC);
#pragma unroll
        for (int q = 0; q < 5; ++q) { const int i = tid + 512 * q; pq[q] = src[i < 2112 ? i : 2111]; } };
    auto lq = [&](int n) { LAS u32x4* dst = (LAS u32x4*)(lds + QB0 + (n & 1) * 33792);
#pragma unroll
        for (int q = 0; q < 5; ++q) { const int i = tid + 512 * q; if (i < 2112) dst[i] = pq[q]; } };
    gq(0); lq(0);
    __syncthreads();
    for (int n = 0; n < 32; ++n) {
        if (n + 1 < 32) gq(n + 1);
        const bf16_t* rl = (const bf16_t*)((const unsigned char*)C.out + (size_t)(item0 + n) * RLREC) + (size_t)(vh * 128 + 16 * w + fr) * 16 + 4 * fq;
        u32x2 Lr[16];
#pragma unroll
        for (int kt = 0; kt < 16; ++kt) Lr[kt] = *(const u32x2*)(rl + (size_t)kt * 4096);
        const int qb = QB0 + (n & 1) * 33792;
        bf16_t* op0 = ORN + (size_t)(si.base + 64 * n + fr) * 1024 + h * 256 + vh * 128 + 16 * w + 4 * fq;
        u32x2 oraw[4]; f32x4 oacc[4];
#pragma unroll
        for (int ti = 0; ti < 4; ++ti) oraw[ti] = *(const u32x2*)(op0 + (size_t)ti * 16 * 1024);
#pragma unroll
        for (int ti = 0; ti < 4; ++ti) { f32x4 acc = (f32x4){0.f, 0.f, 0.f, 0.f};
#pragma unroll
            for (int ks = 0; ks < 8; ++ks) { const bf16x8 sf = ldfrag(lds, ST + (16 * w + fr) * 528 + (32 * ks + 8 * fq) * 2), qf = ldfrag(lds, qb + (16 * ti + fr) * 528 + (32 * ks + 8 * fq) * 2); acc = MFMA16(sf, qf, acc); }
            oacc[ti] = acc; }
        asm volatile("" ::: "memory");
#pragma unroll
        for (int kt = 0; kt < 16; ++kt) { float l4[4]; unpack4(Lr[kt], l4);
            sacc[kt][0] = sacc[kt][0] * cdec + l4[0]; sacc[kt][1] = sacc[kt][1] * cdec + l4[1]; sacc[kt][2] = sacc[kt][2] * cdec + l4[2]; sacc[kt][3] = sacc[kt][3] * cdec + l4[3];
            *(LAS u32x2*)(lds + ST + (16 * w + fr) * 528 + (16 * kt + 4 * fq) * 2) = pack4(sacc[kt][0], sacc[kt][1], sacc[kt][2], sacc[kt][3]); }
#pragma unroll
        for (int ti = 0; ti < 4; ++ti) { float o4[4]; unpack4(oraw[ti], o4); const float qd = __expf(lg * (float)(16 * ti + fr + 1));
            *(u32x2*)(op0 + (size_t)ti * 16 * 1024) = pack4(o4[0] + qd * oacc[ti][0], o4[1] + qd * oacc[ti][1], o4[2] + qd * oacc[ti][2], o4[3] + qd * oacc[ti][3]); }
        if (n + 1 < 32) lq(n + 1);
        __syncthreads();
    }
#pragma unroll
    for (int kt = 0; kt < 16; ++kt)
#pragma unroll
        for (int r = 0; r < 4; ++r) Sout[(size_t)(16 * kt + 4 * fq + r) * 256 + vh * 128 + 16 * w + fr] = sacc[kt][r];
}
__device__ __forceinline__ void ret_task(const Params& P, const Ctx& C, int l, int sq, int h, int vs) {
    int tid = C.tid; asm volatile("" : "+v"(tid)); const SeqInfo si = seq_info(sq); const int lane = tid & 63, w = C.wave, fr = lane & 15, fq = lane >> 4;
    LAS unsigned char* lds = C.lds;
    constexpr int QA = 0, KA = 33792, KAT = 67584, VT = 104448, VDT = 109056, PB = 113664, ST = 122880;
    const bf16_t* Z = WSP(bf16_t, WS_Z); bf16_t* ORN = WSP(bf16_t, WS_ORN); const f32x2* rope = WSP(f32x2, WS_ROPE);
    const float* S0 = si.prompt ? nullptr : P.in[5] + (((size_t)l * 128 + si.b) * 4 + h) * 65536;
    float* Sout = si.prompt ? C.out + OFF_RNP + (((size_t)l * 4 + si.b) * 4 + h) * 65536 : C.out + OFF_RNS + (((size_t)l * 128 + si.b) * 4 + h) * 65536;
    const float lg = __logf(1.f - exp2f(-5.f - (float)h));
    const int Cc = si.T < 64 ? si.T : 64; const float cdec = __expf(lg * (float)Cc);
    const int vi = w & 1, ktb = 4 * (w >> 1);
    f32x4 sacc[4];
#pragma unroll
    for (int m = 0; m < 4; ++m) { const int kt = ktb + m;
        if (S0) {
#pragma unroll
            for (int r = 0; r < 4; ++r) sacc[m][r] = S0[(size_t)(16 * kt + 4 * fq + r) * 256 + vs * 32 + 16 * vi + fr]; }
        else sacc[m] = (f32x4){0.f, 0.f, 0.f, 0.f};
        *(LAS u32x2*)(lds + ST + (16 * vi + fr) * 528 + (16 * kt + 4 * fq) * 2) = pack4(sacc[m][0], sacc[m][1], sacc[m][2], sacc[m][3]); }
    const int i2 = tid & 63, tq = tid >> 6;
    const int nch = (si.T + 63) >> 6;
    for (int n = 0; n < nch; ++n) {
#pragma unroll
        for (int j = 0; j < 8; j += 2) {
            float kt1[2][2], kt2[2][2];
#pragma unroll
            for (int jj = 0; jj < 2; ++jj) { const int t = 8 * tq + j + jj, tl = 64 * n + t;
                float q1a = 0.f, q1b = 0.f, q2a = 0.f, q2b = 0.f, k1a = 0.f, k1b = 0.f, k2a = 0.f, k2b = 0.f;
                if (tl < si.T) { const bf16_t* zr = Z + (size_t)(si.base + tl) * NPAD + h * 256 + 2 * i2;
                    const unsigned xq1 = *(const unsigned*)(zr + ZRQ), xq2 = *(const unsigned*)(zr + ZRQ + 128), xk1 = *(const unsigned*)(zr + ZRK), xk2 = *(const unsigned*)(zr + ZRK + 128);
                    const int pidx = si.prompt ? tl : 2048 + tl;
                    const f32x4 cs = *(const f32x4*)(rope + (size_t)pidx * 128 + 2 * i2);
                    q1a = bflo(xq1) * cs[0] - bflo(xq2) * cs[1]; q2a = bflo(xq1) * cs[1] + bflo(xq2) * cs[0];
                    q1b = bfhi(xq1) * cs[2] - bfhi(xq2) * cs[3]; q2b = bfhi(xq1) * cs[3] + bfhi(xq2) * cs[2];
                    k1a = (bflo(xk1) * cs[0] - bflo(xk2) * cs[1]) * 0.0625f; k2a = (bflo(xk1) * cs[1] + bflo(xk2) * cs[0]) * 0.0625f;
                    k1b = (bfhi(xk1) * cs[2] - bfhi(xk2) * cs[3]) * 0.0625f; k2b = (bfhi(xk1) * cs[3] + bfhi(xk2) * cs[2]) * 0.0625f; }
                *(LAS unsigned*)(lds + QA + t * 528 + i2 * 4) = pk2(q1a, q1b); *(LAS unsigned*)(lds + QA + t * 528 + 256 + i2 * 4) = pk2(q2a, q2b);
                *(LAS unsigned*)(lds + KA + t * 528 + i2 * 4) = pk2(k1a, k1b); *(LAS unsigned*)(lds + KA + t * 528 + 256 + i2 * 4) = pk2(k2a, k2b);
                kt1[jj][0] = k1a; kt1[jj][1] = k1b; kt2[jj][0] = k2a; kt2[jj][1] = k2b; }
            const int t = 8 * tq + j;
            *(LAS unsigned*)(lds + KAT + (2 * i2) * 144 + t * 2) = pk2(kt1[0][0], kt1[1][0]);
            *(LAS unsigned*)(lds + KAT + (2 * i2 + 1) * 144 + t * 2) = pk2(kt1[0][1], kt1[1][1]);
            *(LAS unsigned*)(lds + KAT + (128 + 2 * i2) * 144 + t * 2) = pk2(kt2[0][0], kt2[1][0]);
            *(LAS unsigned*)(lds + KAT + (128 + 2 * i2 + 1) * 144 + t * 2) = pk2(kt2[0][1], kt2[1][1]);
        }
        { const int v = tid & 31, tq4 = tid >> 5;
#pragma unroll
            for (int j = 0; j < 4; j += 2) { float x[2], xd[2];
#pragma unroll
                for (int jj = 0; jj < 2; ++jj) { const int t = 4 * tq4 + j + jj, tl = 64 * n + t; x[jj] = 0.f; xd[jj] = 0.f;
                    if (tl < si.T) { x[jj] = bf2f(Z[(size_t)(si.base + tl) * NPAD + ZRV + h * 256 + vs * 32 + v]); xd[jj] = x[jj] * __expf(lg * (float)(Cc - 1 - t)); } }
                const int t = 4 * tq4 + j;
                *(LAS unsigned*)(lds + VT + v * 144 + t * 2) = pk2(x[0], x[1]); *(LAS unsigned*)(lds + VDT + v * 144 + t * 2) = pk2(xd[0], xd[1]); } }
        __syncthreads();
#pragma unroll
        for (int tt = 0; tt < 2; ++tt) { const int tile = 2 * w + tt, ti = tile >> 2, sj = tile & 3;
            if (16 * ti >= Cc) continue;
            f32x4 acc = (f32x4){0.f, 0.f, 0.f, 0.f};
            if (sj <= ti) {
#pragma unroll
                for (int ks = 0; ks < 8; ++ks) { const bf16x8 kf = ldfrag(lds, KA + (16 * sj + fr) * 528 + (32 * ks + 8 * fq) * 2), qf = ldfrag(lds, QA + (16 * ti + fr) * 528 + (32 * ks + 8 * fq) * 2); acc = MFMA16(kf, qf, acc); }
                const int t = 16 * ti + fr;
#pragma unroll
                for (int r = 0; r < 4; ++r) { const int s = 16 * sj + 4 * fq + r; acc[r] = (s > t) ? 0.f : acc[r] * __expf(lg * (float)(t - s)); } }
            *(LAS u32x2*)(lds + PB + (16 * ti + fr) * 144 + (16 * sj + 4 * fq) * 2) = pack4(acc[0], acc[1], acc[2], acc[3]); }
        __syncthreads();
        if (16 * (w >> 1) < Cc) { const int ti = w >> 1; f32x4 a1 = (f32x4){0.f, 0.f, 0.f, 0.f}, a2 = a1;
#pragma unroll
            for (int ks = 0; ks < 2; ++ks) { const bf16x8 vf = ldfrag(lds, VT + (16 * vi + fr) * 144 + (32 * ks + 8 * fq) * 2), pf = ldfrag(lds, PB + (16 * ti + fr) * 144 + (32 * ks + 8 * fq) * 2); a1 = MFMA16(vf, pf, a1); }
#pragma unroll
            for (int ks = 0; ks < 8; ++ks) { const bf16x8 sf = ldfrag(lds, ST + (16 * vi + fr) * 528 + (32 * ks + 8 * fq) * 2), qf = ldfrag(lds, QA + (16 * ti + fr) * 528 + (32 * ks + 8 * fq) * 2); a2 = MFMA16(sf, qf, a2); }
            const int t = 16 * ti + fr, tl = 64 * n + t; const float qd = __expf(lg * (float)(t + 1));
            if (tl < si.T) *(u32x2*)(ORN + (size_t)(si.base + tl) * 1024 + h * 256 + vs * 32 + 16 * vi + 4 * fq) = pack4(a1[0] + qd * a2[0], a1[1] + qd * a2[1], a1[2] + qd * a2[2], a1[3] + qd * a2[3]); }
        __syncthreads();
#pragma unroll
        for (int m = 0; m < 4; ++m) { const int kt = ktb + m; sacc[m] *= cdec;
#pragma unroll
            for (int ks = 0; ks < 2; ++ks) { const bf16x8 af = ldfrag(lds, KAT + (16 * kt + fr) * 144 + (32 * ks + 8 * fq) * 2), bf = ldfrag(lds, VDT + (16 * vi + fr) * 144 + (32 * ks + 8 * fq) * 2); sacc[m] = MFMA16(af, bf, sacc[m]); }
            *(LAS u32x2*)(lds + ST + (16 * vi + fr) * 528 + (16 * kt + 4 * fq) * 2) = pack4(sacc[m][0], sacc[m][1], sacc[m][2], sacc[m][3]); }
        __syncthreads();
    }
#pragma unroll
    for (int m = 0; m < 4; ++m)
#pragma unroll
        for (int r = 0; r < 4; ++r) Sout[(size_t)(16 * (ktb + m) + 4 * fq + r) * 256 + vs * 32 + 16 * vi + fr] = sacc[m][r];
}

__device__ __forceinline__ void ret_s_task(const Params& P, const Ctx& C, int l, int sq, int h) {
    int tid = C.tid; asm volatile("" : "+v"(tid)); const SeqInfo si = seq_info(sq); const int lane = tid & 63, w = C.wave, fr = lane & 15, fq = lane >> 4;
    LAS unsigned char* lds = C.lds;
    constexpr int QA = 0, KA = 8448, KAT = 16896, VT = 53760, VDT = 58368, PB = 62976, ST = 65280;
    const bf16_t* Z = WSP(bf16_t, WS_Z); bf16_t* ORN = WSP(bf16_t, WS_ORN); const f32x2* rope = WSP(f32x2, WS_ROPE);
    const float* S0 = P.in[5] + (((size_t)l * 128 + si.b) * 4 + h) * 65536;
    float* Sout = C.out + OFF_RNS + (((size_t)l * 128 + si.b) * 4 + h) * 65536;
    const float lg = __logf(1.f - exp2f(-5.f - (float)h)); const float cdec = __expf(lg * 8.f);
    const int vi = w & 1, ktb = 4 * (w >> 1);
    f32x4 nxt[4];
#pragma unroll
    for (int m = 0; m < 4; ++m)
#pragma unroll
        for (int r = 0; r < 4; ++r) nxt[m][r] = S0[(size_t)(16 * (ktb + m) + 4 * fq + r) * 256 + 16 * vi + fr];
    { const int i2 = tid & 63, tq = tid >> 6;
      float k1[2][2], k2[2][2];
#pragma unroll
      for (int jj = 0; jj < 2; ++jj) { const int t = 2 * tq + jj;
          float q1a = 0.f, q1b = 0.f, q2a = 0.f, q2b = 0.f; k1[jj][0] = k1[jj][1] = k2[jj][0] = k2[jj][1] = 0.f;
          if (tq < 4) { const bf16_t* zr = Z + (size_t)(si.base + t) * NPAD + h * 256 + 2 * i2;
              const unsigned xq1 = *(const unsigned*)(zr + ZRQ), xq2 = *(const unsigned*)(zr + ZRQ + 128), xk1 = *(const unsigned*)(zr + ZRK), xk2 = *(const unsigned*)(zr + ZRK + 128);
              const f32x4 cs = *(const f32x4*)(rope + (size_t)(2048 + t) * 128 + 2 * i2);
              q1a = bflo(xq1) * cs[0] - bflo(xq2) * cs[1]; q2a = bflo(xq1) * cs[1] + bflo(xq2) * cs[0];
              q1b = bfhi(xq1) * cs[2] - bfhi(xq2) * cs[3]; q2b = bfhi(xq1) * cs[3] + bfhi(xq2) * cs[2];
              k1[jj][0] = (bflo(xk1) * cs[0] - bflo(xk2) * cs[1]) * 0.0625f; k2[jj][0] = (bflo(xk1) * cs[1] + bflo(xk2) * cs[0]) * 0.0625f;
              k1[jj][1] = (bfhi(xk1) * cs[2] - bfhi(xk2) * cs[3]) * 0.0625f; k2[jj][1] = (bfhi(xk1) * cs[3] + bfhi(xk2) * cs[2]) * 0.0625f; }
          *(LAS unsigned*)(lds + QA + t * 528 + i2 * 4) = pk2(q1a, q1b); *(LAS unsigned*)(lds + QA + t * 528 + 256 + i2 * 4) = pk2(q2a, q2b);
          *(LAS unsigned*)(lds + KA + t * 528 + i2 * 4) = pk2(k1[jj][0], k1[jj][1]); *(LAS unsigned*)(lds + KA + t * 528 + 256 + i2 * 4) = pk2(k2[jj][0], k2[jj][1]); }
      const int t0 = 2 * tq;
      *(LAS unsigned*)(lds + KAT + (2 * i2) * 144 + t0 * 2) = pk2(k1[0][0], k1[1][0]);
      *(LAS unsigned*)(lds + KAT + (2 * i2 + 1) * 144 + t0 * 2) = pk2(k1[0][1], k1[1][1]);
      *(LAS unsigned*)(lds + KAT + (128 + 2 * i2) * 144 + t0 * 2) = pk2(k2[0][0], k2[1][0]);
      *(LAS unsigned*)(lds + KAT + (128 + 2 * i2 + 1) * 144 + t0 * 2) = pk2(k2[0][1], k2[1][1]);
      unsigned z0 = 0u; asm volatile("" : "+v"(z0));
      *(LAS u32x4*)(lds + KAT + (tid >> 1) * 144 + 32 + (tid & 1) * 16) = (u32x4){z0, z0, z0, z0}; }
    __syncthreads();
    if (w == 0) {
        f32x4 acc = (f32x4){0.f, 0.f, 0.f, 0.f};
#pragma unroll
        for (int ks = 0; ks < 8; ++ks) acc = MFMA16(ldfrag(lds, KA + fr * 528 + (32 * ks + 8 * fq) * 2), ldfrag(lds, QA + fr * 528 + (32 * ks + 8 * fq) * 2), acc);
#pragma unroll
        for (int r = 0; r < 4; ++r) { const int ss = 4 * fq + r; acc[r] = (ss > fr) ? 0.f : acc[r] * __expf(lg * (float)(fr - ss)); }
        *(LAS u32x2*)(lds + PB + fr * 144 + 8 * fq) = pack4(acc[0], acc[1], acc[2], acc[3]);
        *(LAS u32x2*)(lds + PB + fr * 144 + 32 + 8 * fq) = (u32x2){0u, 0u};
    }
#pragma unroll 1
    for (int vs0 = 0; vs0 < 8; ++vs0) {
        int vs = vs0; asm volatile("" : "+s"(vs));
        f32x4 sacc[4];
#pragma unroll
        for (int m = 0; m < 4; ++m) sacc[m] = nxt[m];
        if (vs + 1 < 8) {
#pragma unroll
            for (int m = 0; m < 4; ++m)
#pragma unroll
                for (int r = 0; r < 4; ++r) nxt[m][r] = S0[(size_t)(16 * (ktb + m) + 4 * fq + r) * 256 + (vs + 1) * 32 + 16 * vi + fr]; }
#pragma unroll
        for (int m = 0; m < 4; ++m) *(LAS u32x2*)(lds + ST + (16 * vi + fr) * 528 + (16 * (ktb + m) + 4 * fq) * 2) = pack4(sacc[m][0], sacc[m][1], sacc[m][2], sacc[m][3]);
        { const int v = tid & 31, t = tid >> 5; float x = 0.f;
          if (t < 8) x = bf2f(Z[(size_t)(si.base + t) * NPAD + ZRV + h * 256 + vs * 32 + v]);
          const unsigned xb = pk2(x, 0.f) & 0xffffu, xd = pk2(x * __expf(lg * (float)(7 - (t & 7))), 0.f) & 0xffffu;
          *(LAS bf16_t*)(lds + VT + v * 144 + t * 2) = (bf16_t)xb; *(LAS bf16_t*)(lds + VT + v * 144 + 32 + t * 2) = 0;
          *(LAS bf16_t*)(lds + VDT + v * 144 + t * 2) = (bf16_t)(t < 8 ? xd : 0u); *(LAS bf16_t*)(lds + VDT + v * 144 + 32 + t * 2) = 0; }
        __syncthreads();
        if (w < 2) { f32x4 a1 = (f32x4){0.f, 0.f, 0.f, 0.f}, a2 = a1;
            a1 = MFMA16(ldfrag(lds, VT + (16 * vi + fr) * 144 + 16 * fq), ldfrag(lds, PB + fr * 144 + 16 * fq), a1);
#pragma unroll
            for (int ks = 0; ks < 8; ++ks) a2 = MFMA16(ldfrag(lds, ST + (16 * vi + fr) * 528 + (32 * ks + 8 * fq) * 2), ldfrag(lds, QA + fr * 528 + (32 * ks + 8 * fq) * 2), a2);
            const float qd = __expf(lg * (float)(fr + 1));
            if (fr < 8) *(u32x2*)(ORN + (size_t)(si.base + fr) * 1024 + h * 256 + vs * 32 + 16 * vi + 4 * fq) = pack4(a1[0] + qd * a2[0], a1[1] + qd * a2[1], a1[2] + qd * a2[2], a1[3] + qd * a2[3]); }
#pragma unroll
        for (int m = 0; m < 4; ++m) { const int kt = ktb + m; sacc[m] *= cdec;
            sacc[m] = MFMA16(ldfrag(lds, KAT + (16 * kt + fr) * 144 + 16 * fq), ldfrag(lds, VDT + (16 * vi + fr) * 144 + 16 * fq), sacc[m]);
#pragma unroll
            for (int r = 0; r < 4; ++r) Sout[(size_t)(16 * kt + 4 * fq + r) * 256 + vs * 32 + 16 * vi + fr] = sacc[m][r]; }
        __syncthreads();
    }
}
__device__ __forceinline__ void phase2(const Params& P, const Ctx& C, int l, int qi, int tmask) {
    volatile LAS unsigned* lctl = (volatile LAS unsigned*)(C.lds + LDS_CTL_OFF);
    constexpr int NT = 72 + 64 + 32 + 32 + 512 + 512 + 256;
    unsigned* qh = C.ctl + CW_Q + 64 * qi;
    __syncthreads();
    int t = C.bid;
    while (t < NT) {
        unsigned nxt = 0u; if (C.tid == 0) nxt = (unsigned)C.G + xb_add(qh, 1u);
        int ty, sq = 0, a0 = 0, a1 = 0; const int t2 = t - 72;
        if (t < 72) { ty = 6; a0 = t; }
        else if (t2 < 64) { ty = 0; sq = t2 >> 4; a0 = t2 & 15; }
        else if (t2 < 96) { const int u = t2 - 64; ty = 4; sq = u >> 3; a0 = (u >> 1) & 3; a1 = u & 1; }
        else if (t2 < 128) { const int u = t2 - 96; ty = 3; sq = u >> 3; a0 = u & 7; }
        else if (t2 < 384) { const int u = t2 - 128; ty = 2; sq = 4 + (u >> 1); a0 = u & 1; }
        else if (t2 < 896) { const int u = t2 - 384; ty = 1; sq = 4 + (u >> 2); a0 = u & 3; }
        else { const int u = t2 - 896; ty = 5; sq = 4 + (u >> 2); a0 = u & 3; }
        if (ty == 0) { if (tmask & 1) rwkv_task(P, C, l, sq, a0); }
        else if (ty == 1) { if (tmask & 2) ret_s_task(P, C, l, sq, a0); }
        else if (ty == 2) { if (tmask & 4) hgrn_task(P, C, l, sq, a0); }
        else if (ty == 3) { if (tmask & 4) hgrn_b_task(P, C, l, sq, a0); }
        else if (ty == 4) { if (tmask & 2) ret_b_task(P, C, l, sq, a0, a1); }
        else if (ty == 5) { if (tmask & 1) rwkv_s_task(P, C, l, sq, a0); }
        else {
            pg8::Gemm g{WSP(bf16_t, WS_XB), WSP(bf16_t, WS_WIN) + (size_t)l * NPAD * 2048, M, NPAD, 2048, 2048}; pg8::SingleOrder S1{a0 < 64 ? 8 * (a0 >> 4) + (a0 & 7) : 32 + (a0 & 3), 71 + (a0 < 64 ? (a0 >> 3) & 1 : (a0 >> 2) & 1)};
            EpiZ E{WSP(bf16_t, WS_Z), WSP(float, WS_SS) + (size_t)l * M};
            pg8::gemm_phase<EpiZ, pg8::SingleOrder>(C.lds, g, S1, E); }
        __syncthreads();
        if (C.tid == 0) lctl[4] = nxt;
        __syncthreads();
        t = (int)lctl[4];
    }
}

template <int BR>
__device__ __forceinline__ void p2c_branch(const Params& P, const Ctx& C, int l, int lane, int gw, int NGW) {
    const int c0 = 16 * lane;
    const bf16_t* SRC = (BR == 0 ? WSP(bf16_t, WS_OHG) : BR == 1 ? WSP(bf16_t, WS_YRW) : WSP(bf16_t, WS_ORN)) + c0;
    const bf16_t* GP = WSP(bf16_t, WS_Z) + ZG + BR * 1024 + c0;
    const bf16_t* VP = WSP(bf16_t, WS_VB) + (size_t)l * M * 1024 + c0;
    const float* BON = WSP(float, WS_BONUS) + (lane >> 2);
    bf16_t* YS = WSP(bf16_t, WS_YS) + (size_t)BR * M * 1024 + c0;
    float k0[16], k1[16];
    if (BR == 0) { const float* hn = P.in[11] + l * 128 + (c0 & 127);
#pragma unroll
        for (int j = 0; j < 16; ++j) k0[j] = hn[j]; }
    if (BR == 1) { const float* lw = P.in[23] + l * 1024 + c0; const float* lbb = P.in[24] + l * 1024 + c0;
#pragma unroll
        for (int j = 0; j < 16; ++j) { k0[j] = lw[j]; k1[j] = lbb[j]; } }
    u32x4 cs0, cs1, cg0, cg1, cv0, cv1; float cb = 0.f;
    { const int g = gw; const bf16_t* src = SRC + (size_t)g * 1024; const bf16_t* gp = GP + (size_t)g * NPAD;
      cs0 = *(const u32x4*)src; cs1 = *(const u32x4*)(src + 8); cg0 = *(const u32x4*)gp; cg1 = *(const u32x4*)(gp + 8);
      if (BR == 1) { const bf16_t* vp = VP + (size_t)g * 1024; cv0 = *(const u32x4*)vp; cv1 = *(const u32x4*)(vp + 8); cb = BON[(size_t)g * 16]; } }
#pragma unroll 1
    for (int g = gw; g < M; g += NGW) {
        const int gn = (g + NGW < M) ? g + NGW : g;
        u32x4 ns0, ns1, ng0, ng1, nv0, nv1; float nb = 0.f;
        { const bf16_t* src = SRC + (size_t)gn * 1024; const bf16_t* gp = GP + (size_t)gn * NPAD;
          ns0 = *(const u32x4*)src; ns1 = *(const u32x4*)(src + 8); ng0 = *(const u32x4*)gp; ng1 = *(const u32x4*)(gp + 8);
          if (BR == 1) { const bf16_t* vp = VP + (size_t)gn * 1024; nv0 = *(const u32x4*)vp; nv1 = *(const u32x4*)(vp + 8); nb = BON[(size_t)gn * 16]; } }
        __builtin_amdgcn_sched_barrier(0);
        float x[16], gt[16], y[16];
        { float a[8], b[8]; unpack8(cs0, a); unpack8(cs1, b);
#pragma unroll
            for (int j = 0; j < 8; ++j) { x[j] = a[j]; x[8 + j] = b[j]; }
            unpack8(cg0, a); unpack8(cg1, b);
#pragma unroll
            for (int j = 0; j < 8; ++j) { gt[j] = siluf(a[j]); gt[8 + j] = siluf(b[j]); } }
        if (BR == 0) { float ss = 0.f;
#pragma unroll
            for (int j = 0; j < 16; ++j) ss += x[j] * x[j];
            ss = red8(ss); const float rs = rsqrtf(ss * (1.f / 128.f) + EPS);
#pragma unroll
            for (int j = 0; j < 16; ++j) y[j] = x[j] * rs * k0[j] * gt[j]; }
        else if (BR == 1) { float sm = 0.f;
#pragma unroll
            for (int j = 0; j < 16; ++j) sm += x[j];
            sm = red4(sm); const float mu = sm * (1.f / 64.f); float sv = 0.f;
#pragma unroll
            for (int j = 0; j < 16; ++j) { const float d = x[j] - mu; sv += d * d; }
            sv = red4(sv); const float rs = rsqrtf(sv * (1.f / 64.f) + 64e-5f);
            float vv[16]; { float a[8], b[8]; unpack8(cv0, a); unpack8(cv1, b);
#pragma unroll
                for (int j = 0; j < 8; ++j) { vv[j] = a[j]; vv[8 + j] = b[j]; } }
#pragma unroll
            for (int j = 0; j < 16; ++j) y[j] = ((x[j] - mu) * rs * k0[j] + k1[j] + cb * vv[j]) * gt[j]; }
        else { float ss = 0.f;
#pragma unroll
            for (int j = 0; j < 16; ++j) ss += x[j] * x[j];
            ss = red16(ss); const float rs = rsqrtf(ss * (1.f / 256.f) + EPS);
#pragma unroll
            for (int j = 0; j < 16; ++j) y[j] = x[j] * rs * gt[j]; }
        u32x4 o0, o1; o0.x = pk2(y[0], y[1]); o0.y = pk2(y[2], y[3]); o0.z = pk2(y[4], y[5]); o0.w = pk2(y[6], y[7]); o1.x = pk2(y[8], y[9]); o1.y = pk2(y[10], y[11]); o1.z = pk2(y[12], y[13]); o1.w = pk2(y[14], y[15]);
        bf16_t* dst = YS + (size_t)g * 1024; *(u32x4*)dst = o0; *(u32x4*)(dst + 8) = o1;
        __builtin_amdgcn_sched_barrier(0);
        cs0 = ns0; cs1 = ns1; cg0 = ng0; cg1 = ng1; if (BR == 1) { cv0 = nv0; cv1 = nv1; cb = nb; }
    }
}
__device__ __forceinline__ void phase2c(const Params& P, const Ctx& C, int l) {
    int lane = C.lane; asm volatile("" : "+v"(lane));
    const int gw = C.bid * 8 + C.wave, NGW = C.G * 8;
    p2c_branch<0>(P, C, l, lane, gw, NGW);
    asm volatile("" : "+v"(lane));
    p2c_branch<1>(P, C, l, lane, gw, NGW);
    asm volatile("" : "+v"(lane));
    p2c_branch<2>(P, C, l, lane, gw, NGW);
}

template <int L>
__device__ __forceinline__ void phase6_t(const Params& P, const Ctx& C) {
    constexpr int l = L;
    int lane = C.lane; asm volatile("" : "+v"(lane));
    const int gw = C.bid * 8 + C.wave, NGW = C.G * 8;
    const float* np = P.in[27] + l * 2048 + 4 * lane; const float* ssu = WSP(float, WS_SS) + (size_t)(2 + l) * M;
    const bf16_t* U = WSP(bf16_t, WS_U) + 4 * lane; bf16_t* XN = WSP(bf16_t, WS_XNB) + 4 * lane;
    f32x4 gg[8];
#pragma unroll
    for (int j = 0; j < 8; ++j) gg[j] = *(const f32x4*)(np + 256 * j);
    volatile LAS int* tb = (volatile LAS int*)C.lds; const float* PT = WSP(float, WS_RWP);
    if (L == 1) { const int tid = C.wave * 64 + lane; __syncthreads();
        if (tid < 288) tb[tid] = 0;
        __syncthreads();
        if (tid < 32) { pg8::StaticOrder S; S.init(M, 2048, C.G, 0); pg8::Unit u; S.tile(256 + tid, u); tb[u.pm * 8 + u.pn] = tid + 1; }
        __syncthreads(); }
    f32x4 cx[L == 0 ? 8 : 1]; u32x2 cxb[L == 0 ? 1 : 8]; u32x2 cu[8]; float css;
    { const int m = gw; css = ssu[m];
      if (L == 0) { const float* xr = ((m < MP) ? P.in[0] + (size_t)m * 2048 : P.in[1] + (size_t)(m - MP) * 2048) + 4 * lane;
#pragma unroll
          for (int j = 0; j < 8; ++j) cx[L == 0 ? j : 0] = *(const f32x4*)(xr + 256 * j); }
      else { const bf16_t* xr = WSP(bf16_t, WS_XB) + (size_t)m * 2048 + 4 * lane;
#pragma unroll
          for (int j = 0; j < 8; ++j) cxb[L == 0 ? 0 : j] = *(const u32x2*)(xr + 256 * j); }
#pragma unroll
      for (int j = 0; j < 8; ++j) cu[j] = *(const u32x2*)(U + (size_t)m * 2048 + 256 * j); }
#pragma unroll 1
    for (int m = gw; m < M; m += NGW) {
        const int mn = (m + NGW < M) ? m + NGW : m;
        f32x4 nx[L == 0 ? 8 : 1]; u32x2 nxb[L == 0 ? 1 : 8]; u32x2 nu[8]; float nss = ssu[mn];
        if (L == 0) { const float* xr = ((mn < MP) ? P.in[0] + (size_t)mn * 2048 : P.in[1] + (size_t)(mn - MP) * 2048) + 4 * lane;
#pragma unroll
            for (int j = 0; j < 8; ++j) nx[L == 0 ? j : 0] = *(const f32x4*)(xr + 256 * j); }
        else { const bf16_t* xr = WSP(bf16_t, WS_XB) + (size_t)mn * 2048 + 4 * lane;
#pragma unroll
            for (int j = 0; j < 8; ++j) nxb[L == 0 ? 0 : j] = *(const u32x2*)(xr + 256 * j); }
#pragma unroll
        for (int j = 0; j < 8; ++j) nu[j] = *(const u32x2*)(U + (size_t)mn * 2048 + 256 * j);
        __builtin_amdgcn_sched_barrier(0);
        float uf[8][4];
#pragma unroll
        for (int j = 0; j < 8; ++j) unpack4(cu[j], uf[j]);
        float rs;
        if (L == 1) { const int pmr = m >> 8; float sq = 0.f;
#pragma unroll
            for (int j = 0; j < 8; ++j) { const int e = __builtin_amdgcn_readfirstlane(tb[pmr * 8 + j]);
                if (e) { const float* pp = PT + (size_t)(e - 1) * 65536 + (m & 255) * 256 + 4 * lane;
                    const f32x4 sacc = (*(const f32x4*)pp + *(const f32x4*)(pp + (size_t)32 * 65536)) + (*(const f32x4*)(pp + (size_t)64 * 65536) + *(const f32x4*)(pp + (size_t)96 * 65536));
                    uf[j][0] = sacc[0]; uf[j][1] = sacc[1]; uf[j][2] = sacc[2]; uf[j][3] = sacc[3]; }
                sq += (uf[j][0] * uf[j][0] + uf[j][1] * uf[j][1]) + (uf[j][2] * uf[j][2] + uf[j][3] * uf[j][3]); }
            rs = rsqrtf(wave_sum(sq) * (1.f / 2048.f) + EPS); }
        else rs = rsqrtf(css * (1.f / 2048.f) + EPS);
        bf16_t* xb = XN + (size_t)m * 2048;
#pragma unroll
        for (int j = 0; j < 8; ++j) { const f32x4 g = gg[j]; const float (&u)[4] = uf[j];
            f32x4 x; if (L == 0) x = cx[L == 0 ? j : 0]; else { float t4[4]; unpack4(cxb[L == 0 ? 0 : j], t4); x = (f32x4){t4[0], t4[1], t4[2], t4[3]}; }
            *(u32x2*)(xb + 256 * j) = pack4(x[0] + u[0] * rs * g[0], x[1] + u[1] * rs * g[1], x[2] + u[2] * rs * g[2], x[3] + u[3] * rs * g[3]); }
        __builtin_amdgcn_sched_barrier(0);
        css = nss;
#pragma unroll
        for (int j = 0; j < 8; ++j) { cu[j] = nu[j]; if (L == 0) cx[L == 0 ? j : 0] = nx[L == 0 ? j : 0]; else cxb[L == 0 ? 0 : j] = nxb[L == 0 ? 0 : j]; }
    }
}
__device__ __forceinline__ void phase6(const Params& P, const Ctx& C, int l) { if (l == 0) phase6_t<0>(P, C); else phase6_t<1>(P, C); }

__global__ void __launch_bounds__(NTHREADS, 2) fwd_megakernel(Params p) {
    extern __shared__ __attribute__((aligned(16))) unsigned char lds_raw[];
    Ctx C;
    C.out = p.out; C.ws = p.ws;
    C.lds = (LAS unsigned char*)lds_raw;
    C.tid = threadIdx.x; C.lane = C.tid & 63; C.wave = __builtin_amdgcn_readfirstlane(C.tid >> 6); C.G = gridDim.x; C.bid = blockIdx.x;
    C.ctl = (unsigned*)(p.ws + WS_CTL);
    volatile LAS unsigned* lctl = (volatile LAS unsigned*)(C.lds + LDS_CTL_OFF);
    if (C.tid < 64) lctl[C.tid] = 0u;
    __syncthreads();
    XcdBarrier bar = xcd_barrier_post(C.ctl, lctl);
    cg::grid_group grid = cg::this_grid();
#ifndef DUPX
#define DUPX -1
#endif
#define NREP(id) ((DUPX) == (id) ? 2 : 1)
#define XBAR() xcd_barrier(bar)
    for (int rep = 0; rep < NREP(0); ++rep) { if (rep) __syncthreads(); phase0(p, C); }
    grid.sync();

#pragma unroll 1
    for (int l = 0; l < 2; ++l) {
        int bidl = C.bid, Gl = C.G; asm volatile("" : "+s"(bidl), "+s"(Gl)); Ctx CL = C; CL.bid = bidl; CL.G = Gl;
        for (int rep = 0; rep < NREP(1); ++rep) { if (rep) XBAR();
          pg8::Gemm g{WSPL(bf16_t, WS_XB), WSPL(bf16_t, WS_WIN) + (size_t)l * NPAD * 2048, M, 71 * 256, 2048, 2048}; pg8::StaticOrder S; S.init(M, 71 * 256, CL.G, CL.bid);
          EpiZ E{WSPL(bf16_t, WS_Z), WSPL(float, WS_SS) + (size_t)l * M};
          pg8::gemm_phase<EpiZ, pg8::StaticOrder>(CL.lds, g, S, E); }
        XBAR();
        for (int rep = 0; rep < NREP(2); ++rep) { if (rep) XBAR();
            volatile LAS unsigned* lq = (volatile LAS unsigned*)(CL.lds + LDS_CTL_OFF);
            unsigned* qh = CL.ctl + CW_Q + 64 * (2 + l + 8 * rep);
            __syncthreads();
            int it = CL.bid;
            while (it < 576 + 512 + 1024) {
                unsigned nxt = 0u; if (CL.tid == 0) nxt = (unsigned)CL.G + xb_add(qh, 1u);
                if (it < 576) { const int t = it < 64 ? 512 + it : it - 64;
                    if (t < 512) { if (l == 0) p2a_item<0, false>(p, CL, t); else p2a_item<1, false>(p, CL, t); } else { if (l == 0) p2a_item<0, true>(p, CL, t); else p2a_item<1, true>(p, CL, t); }
                    int lane2 = CL.lane; asm volatile("" : "+v"(lane2)); LAS unsigned char* wl = CL.lds + CL.wave * 13312;
                    for (int hh = 0; hh < 2; ++hh) { const int hd = 2 * CL.wave + hh;
                        if (t < 512) rwkv_prep_item(p, CL, l, hd * 640 + t, wl, lane2);
                        else { rwkv_prep_item(p, CL, l, hd * 640 + 512 + 2 * (t - 512), wl, lane2); rwkv_prep_item(p, CL, l, hd * 640 + 512 + 2 * (t - 512) + 1, wl, lane2); } } }
                else if (it < 576 + 512) ret_a_item(p, CL, l, it - 576);
                else hgrn_a_item(p, CL, l, it - 576 - 512);
                __syncthreads();
                if (CL.tid == 0) lq[4] = nxt;
                __syncthreads();
                it = (int)lq[4];
            }
        }
        XBAR();
        for (int rep = 0; rep < NREP(4); ++rep) { if (rep) XBAR(); phase2(p, CL, l, l + 8 * rep, 7); }
        XBAR();
        for (int rep = 0; rep < NREP(5); ++rep) phase2c(p, CL, l);
        XBAR();
        for (int rep = 0; rep < NREP(6); ++rep) { if (rep) XBAR();
          { pg8::Gemm g{WSPL(bf16_t, WS_YS), WSPL(bf16_t, WS_WBR) + (size_t)l * 3 * 2048 * 1024, 3 * M, 3 * 2048, 1024, 1024}; pg8::BranchOrder S; S.s.init(M, 2048, CL.G, CL.bid);
            EpiBranch E{WSPL(bf16_t, WS_Z), WSPL(bf16_t, WS_MB)};
            pg8::gemm_phase<EpiBranch, pg8::BranchOrder>(CL.lds, g, S, E);
            pg8::ExtraOrder S2; S2.s.init(M, 2048, CL.G, CL.bid); EpiBranchAtomic E2{WSPL(bf16_t, WS_Z), WSPL(bf16_t, WS_RWP)};
            if (rep == 0) pg8::gemm_phase<EpiBranchAtomic, pg8::ExtraOrder>(CL.lds, g, S2, E2); }
          if (rep == 0 && CL.bid < 160) {
            pg8::Gemm g2{WSPL(bf16_t, WS_PB) + (size_t)l * M * 256, WSPL(bf16_t, WS_WUP) + (size_t)l * 2048 * 256, M, 2048, 256, 256}; pg8::StaticOrder S3; S3.init(M, 2048, 160, CL.bid);
            EpiSS E3{WSPL(bf16_t, WS_ER), WSPL(float, WS_SS) + (size_t)(4 + l) * M};
            pg8::gemm_phase<EpiSS, pg8::StaticOrder>(CL.lds, g2, S3, E3);
            if (l == 0) conv_layer_items(p, CL, 0, 21760, 25856, CL.bid * 8 + CL.wave, 160 * 8); }
        }
        XBAR();
        { int tz = CL.tid; asm volatile("" : "+v"(tz)); pg8::StaticOrder S; S.init(M, 2048, CL.G, 0); const bf16_t* sp = WSPL(bf16_t, WS_RWP); bf16_t* Mb = WSPL(bf16_t, WS_MB);
          for (int i = CL.bid * NTHREADS + tz; i < 32 * 65536 / 8; i += CL.G * NTHREADS) { const int t = i >> 13, r = (i >> 5) & 255, c8 = (i & 31) * 8; pg8::Unit u; S.tile(256 + t, u);
              float a[8], b[8], c[8];
              unpack8(*(const u32x4*)(sp + (size_t)t * 65536 + r * 256 + c8), a); unpack8(*(const u32x4*)(sp + (size_t)(32 + t) * 65536 + r * 256 + c8), b); unpack8(*(const u32x4*)(sp + (size_t)(64 + t) * 65536 + r * 256 + c8), c);
              u32x4 w; w.x = pk2(a[0] + b[0] + c[0], a[1] + b[1] + c[1]); w.y = pk2(a[2] + b[2] + c[2], a[3] + b[3] + c[3]); w.z = pk2(a[4] + b[4] + c[4], a[5] + b[5] + c[5]); w.w = pk2(a[6] + b[6] + c[6], a[7] + b[7] + c[7]);
              *(u32x4*)(Mb + (size_t)(u.pm * 256 + r) * 2048 + u.pn * 256 + c8) = w; } }
        XBAR();
        for (int rep = 0; rep < NREP(7); ++rep) { if (rep) XBAR();
          pg8::Gemm g{WSPL(bf16_t, WS_MB), WSPL(bf16_t, WS_WOUT) + (size_t)l * 2048 * 2048, M, 2048, 2048, 2048}; pg8::StaticOrder S; S.init(M, 2048, CL.G, CL.bid);
          EpiSS E{WSPL(bf16_t, WS_U), WSPL(float, WS_SS) + (size_t)(rep ? 6 : 2 + l) * M};
          if (l == 0) pg8::gemm_phase<EpiSS, pg8::StaticOrder>(CL.lds, g, S, E);
          else {
            pg8::FirstRound S1; S1.s = S; pg8::gemm_phase<EpiSS, pg8::FirstRound>(CL.lds, g, S1, E);
            pg8::Gemm gq = g; gq.K = 512; pg8::PieceOrder S2; S2.s = S; EpiPart E2{WSPL(float, WS_RWP)};
            pg8::gemm_phase<EpiPart, pg8::PieceOrder>(CL.lds, gq, S2, E2); }
          if (l == 0 && rep == 0 && CL.bid >= 32) conv_layer_items(p, CL, 1, 0, CONV_SPLIT, (CL.bid - 32) * 8 + CL.wave, (CL.G - 32) * 8); }
        XBAR();
        for (int rep = 0; rep < NREP(8); ++rep) phase6(p, CL, l);
        XBAR();
        for (int rep = 0; rep < NREP(9); ++rep) { if (rep) XBAR();
          pg8::Gemm g{WSPL(bf16_t, WS_XNB), WSPL(bf16_t, WS_WGATE) + (size_t)l * 2048 * 2048, M, 2048, 2048, 2048}; pg8::StaticOrder S; S.init(M, 2048, CL.G, CL.bid);
          EpiGate E{WSPL(bf16_t, WS_XNB), WSPL(bf16_t, WS_ER), WSPL(float, WS_SS) + (size_t)(4 + l) * M, p.in[29] + l * 2048,
                    l == 0 ? nullptr : CL.out + OFF_Y, l == 0 ? WSPL(bf16_t, WS_XB) : nullptr, l == 0 ? WSPL(float, WS_SS) + (rep ? 6 : 1) * M : nullptr};
          if (l == 0) pg8::gemm_phase<EpiGate, pg8::StaticOrder>(CL.lds, g, S, E);
          else {
            pg8::FirstRound S1; S1.s = S; pg8::gemm_phase<EpiGate, pg8::FirstRound>(CL.lds, g, S1, E);
            pg8::Gemm gq = g; gq.K = 512; pg8::PieceOrder S2; S2.s = S; EpiPart E2{WSPL(float, WS_RWP)};
            pg8::gemm_phase<EpiPart, pg8::PieceOrder>(CL.lds, gq, S2, E2); }
          if (l == 0 && rep == 0 && CL.bid >= 32) conv_layer_items(p, CL, 1, CONV_SPLIT, CONV_ITEMS, (CL.bid - 32) * 8 + CL.wave, (CL.G - 32) * 8); }
        XBAR();
        if (l == 1) {
            int tz = CL.tid; asm volatile("" : "+v"(tz)); pg8::StaticOrder S; S.init(M, 2048, CL.G, 0); const float* PT = WSPL(float, WS_RWP);
            const bf16_t* XNp = WSPL(bf16_t, WS_XNB); const bf16_t* ERp = WSPL(bf16_t, WS_ER); const float* sse = WSPL(float, WS_SS) + (size_t)(4 + l) * M; const float* pnorm = p.in[29] + l * 2048; float* Y = CL.out + OFF_Y;
            for (int i = CL.bid * NTHREADS + tz; i < 32 * 65536 / 8; i += CL.G * NTHREADS) { const int sp = i >> 13, r = (i >> 5) & 255, c8 = (i & 31) * 8; pg8::Unit u; S.tile(256 + sp, u);
                const int row = u.pm * 256 + r, col = u.pn * 256 + c8; const size_t off = (size_t)row * 2048 + col;
                const float* pp = PT + (size_t)sp * 65536 + r * 256 + c8;
                const f32x4 a0 = (*(const f32x4*)pp + *(const f32x4*)(pp + (size_t)32 * 65536)) + (*(const f32x4*)(pp + (size_t)64 * 65536) + *(const f32x4*)(pp + (size_t)96 * 65536));
                const f32x4 a1 = (*(const f32x4*)(pp + 4) + *(const f32x4*)(pp + 4 + (size_t)32 * 65536)) + (*(const f32x4*)(pp + 4 + (size_t)64 * 65536) + *(const f32x4*)(pp + 4 + (size_t)96 * 65536));
                const u32x4 x = *(const u32x4*)(XNp + off), e = *(const u32x4*)(ERp + off); const float rs = rsqrtf(sse[row] * (1.0f / 2048.0f) + EPS);
                const f32x4 p0 = *(const f32x4*)(pnorm + col), p1 = *(const f32x4*)(pnorm + col + 4);
                f32x4 o0, o1;
                o0[0] = bflo(x.x) + bflo(e.x) * rs * p0[0] * sigm(a0[0]); o0[1] = bfhi(x.x) + bfhi(e.x) * rs * p0[1] * sigm(a0[1]);
                o0[2] = bflo(x.y) + bflo(e.y) * rs * p0[2] * sigm(a0[2]); o0[3] = bfhi(x.y) + bfhi(e.y) * rs * p0[3] * sigm(a0[3]);
                o1[0] = bflo(x.z) + bflo(e.z) * rs * p1[0] * sigm(a1[0]); o1[1] = bfhi(x.z) + bfhi(e.z) * rs * p1[1] * sigm(a1[1]);
                o1[2] = bflo(x.w) + bflo(e.w) * rs * p1[2] * sigm(a1[2]); o1[3] = bfhi(x.w) + bfhi(e.w) * rs * p1[3] * sigm(a1[3]);
                *(f32x4*)(Y + off) = o0; *(f32x4*)(Y + off + 4) = o1; } }
    }
}

extern "C" void kernel_launch(void* const* d_in, const int* in_sizes, int n_in, void* d_out, int out_size, void* d_ws, size_t ws_size, hipStream_t stream) {
    static int grid_blocks = 0;
    if (!grid_blocks) {
        int dev = 0, cus = 0, per_cu = 0;
        (void)hipGetDevice(&dev);
        (void)hipDeviceGetAttribute(&cus, hipDeviceAttributeMultiprocessorCount, dev);
        (void)hipFuncSetAttribute((const void*)fwd_megakernel, hipFuncAttributeMaxDynamicSharedMemorySize, LDS_BYTES);
        (void)hipOccupancyMaxActiveBlocksPerMultiprocessor(&per_cu, (const void*)fwd_megakernel, NTHREADS, LDS_BYTES);
        if (per_cu < 1) { fprintf(stderr, "occupancy query says %d blocks/CU\n", per_cu); per_cu = 1; }
        if (per_cu > 1) per_cu = 1;
        grid_blocks = cus * per_cu;
        if (ws_size < WS_END || n_in != 31 || out_size != 140846592) fprintf(stderr, "kernel_launch: unexpected sizes ws %zu (need %zu) n_in %d out %d\n", ws_size, (size_t)WS_END, n_in, out_size);
    }
    (void)hipMemsetAsync((char*)d_ws + WS_CTL, 0, CTL_BYTES, stream);
    Params p{};
    for (int i = 0; i < 31; ++i) p.in[i] = (const float*)d_in[i];
    p.out = (float*)d_out; p.ws = (unsigned char*)d_ws;
    void* args[] = {&p};
    hipError_t e = hipLaunchCooperativeKernel((const void*)fwd_megakernel, dim3(grid_blocks), dim3(NTHREADS), args, LDS_BYTES, stream);
    if (e != hipSuccess) fprintf(stderr, "cooperative launch failed: %s (grid %d)\n", hipGetErrorString(e), grid_blocks);
}
```
